# Optimizing an MI355X kernel written in HIP

```python
import jax
import jax.numpy as jnp
from jax import lax
import numpy as np

D_MODEL = 1024
BATCH = 8
SEQ = 2048
DEPTH = 4
DEC_BATCH = 32
DEC_SEQ = 4
PAST_LEN = 8192
PAGE_SIZE = 128

N_MIXERS = 3
N_LAYERS_A = (DEPTH + 2) // 3
N_LAYERS_B = (DEPTH + 1) // 3
N_LAYERS_C = DEPTH // 3

D_CONV = D_MODEL
CONV_A_WIDTH = 3

N_HEADS = 16
HEAD_DIM = D_MODEL // N_HEADS
N_KV = 2
HPG = N_HEADS // N_KV
D_ATT = N_HEADS * HEAD_DIM
CMP_BLOCK = 32
SLC_BLOCK = 64
CMP_PER_SLC = SLC_BLOCK // CMP_BLOCK
TOP_N = 16
N_LOCAL = 2
WINDOW = 512
Q_BLOCK = 32
NEG_INF = -1e30
FORCE = 1e9

D_RNN = D_MODEL
N_RG_BLOCKS = 4
RG_BLOCK = D_RNN // N_RG_BLOCKS
CONV_C_WIDTH = 4
RG_C = 8.0

ALPHA = (2 * DEPTH) ** 0.25
BETA = (8 * DEPTH) ** -0.25
LN_EPS = 1e-5

kernel_name = 'hybrid_conv_nsa_rglru_deepnorm_step'


def layer_norm(x, g, b):
    xf = x.astype(jnp.float32)
    mu = jnp.mean(xf, axis=-1, keepdims=True)
    var = jnp.mean(jnp.square(xf - mu), axis=-1, keepdims=True)
    return ((xf - mu) * lax.rsqrt(var + LN_EPS) * g.astype(jnp.float32) + b.astype(jnp.float32)).astype(x.dtype)


def causal_dwconv(u, buf, w):
    width = w.shape[0]
    t_len = u.shape[1]
    ext = jnp.concatenate([buf.astype(u.dtype), u], axis=1)
    out = ext[:, 0:t_len] * w[0]
    for k in range(1, width):
        out = out + ext[:, k:k + t_len] * w[k]
    return out, ext[:, ext.shape[1] - (width - 1):]


def masked_softmax(s, valid):
    s = jnp.where(valid, s, NEG_INF)
    return jax.nn.softmax(s, axis=-1) * valid


def alibi_slopes():
    h = jnp.arange(1, N_HEADS + 1, dtype=jnp.float32)
    return (2.0 ** (-8.0 * h / N_HEADS)).reshape(N_KV, HPG)


def short_conv_mixer(x, buf, w_in, conv_w, w_out):
    h, b_gate, c_gate, z = jnp.split(x @ w_in, 4, axis=-1)
    conv, new_buf = causal_dwconv(c_gate * h, buf, conv_w)
    return (jax.nn.silu(z) * b_gate * conv) @ w_out, new_buf


def rglru_mixer(x, h0, buf, w_in, conv_w, conv_b, w_a, b_a, w_x, b_x, lam, w_out):
    bsz, t_len, _ = x.shape
    u, z = jnp.split(x @ w_in, 2, axis=-1)
    uc, new_buf = causal_dwconv(u, buf, conv_w)
    uc = uc + conv_b
    ub = uc.reshape(bsz, t_len, N_RG_BLOCKS, RG_BLOCK)
    r = jax.nn.sigmoid(jnp.einsum('btni,nij->btnj', ub, w_a).reshape(bsz, t_len, D_RNN) + b_a)
    i = jax.nn.sigmoid(jnp.einsum('btni,nij->btnj', ub, w_x).reshape(bsz, t_len, D_RNN) + b_x)
    log_a = (-RG_C * jax.nn.softplus(-lam.astype(jnp.float32))) * r.astype(jnp.float32)
    a = jnp.exp(log_a)
    b = jnp.sqrt(-jnp.expm1(2.0 * log_a)) * (i * uc).astype(jnp.float32)
    b = b.at[:, 0].add(a[:, 0] * h0.astype(jnp.float32))

    def combine(left, right):
        return left[0] * right[0], right[0] * left[1] + right[1]

    _, h = lax.associative_scan(combine, (a, b), axis=1)
    y = (jax.nn.silu(z) * h.astype(x.dtype)) @ w_out
    return y, h[:, -1].astype(x.dtype), new_buf


def nsa_mixer(x, past_rows, win_buf, w_in, w_cmp, w_out):
    bsz, t_len, _ = x.shape
    p_len = past_rows.shape[1]
    l_len = p_len + t_len
    n_kvcols = 6 * N_KV * HEAD_DIM
    proj = x @ w_in
    q = proj[..., :D_ATT].reshape(bsz, t_len, N_KV, HPG, HEAD_DIM) * (HEAD_DIM ** -0.5)
    kv = proj[..., D_ATT:D_ATT + n_kvcols].reshape(bsz, t_len, 6, N_KV, HEAD_DIM)
    gates = jax.nn.sigmoid(proj[..., D_ATT + n_kvcols:D_ATT + n_kvcols + 3 * N_HEADS]).reshape(bsz, t_len, 3, N_KV, HPG)
    z = proj[..., D_ATT + n_kvcols + 3 * N_HEADS:]
    rows = kv[:, :, :4]
    win_new = kv[:, :, 4:]
    dt = rows.dtype
    full = jnp.concatenate([past_rows.astype(dt), rows], axis=1)

    n_cmp = l_len // CMP_BLOCK
    blocks = full[:, :n_cmp * CMP_BLOCK, :2].reshape(bsz, n_cmp, CMP_BLOCK, 2, N_KV, HEAD_DIM)
    kv_c = jnp.einsum('bnjcgd,cjgd->bncgd', blocks, w_cmp)
    k_c, v_c = kv_c[:, :, 0], kv_c[:, :, 1]
    cmp_end = jnp.arange(n_cmp) * CMP_BLOCK + (CMP_BLOCK - 1)

    n_slc = -(-l_len // SLC_BLOCK)
    slc = jnp.pad(full[:, :, 2:], ((0, 0), (0, n_slc * SLC_BLOCK - l_len), (0, 0), (0, 0), (0, 0)))
    slc = slc.reshape(bsz, n_slc, SLC_BLOCK, 2, N_KV, HEAD_DIM)
    k_sl = slc[:, :, :, 0].transpose(0, 3, 1, 2, 4)
    v_sl = slc[:, :, :, 1].transpose(0, 3, 1, 2, 4)
    n_sel = min(TOP_N, n_slc)

    n_pad = WINDOW - win_buf.shape[1]
    win = jnp.concatenate([jnp.zeros((bsz, n_pad, 2, N_KV, HEAD_DIM), dt), win_buf.astype(dt), win_new], axis=1)

    qb_len = Q_BLOCK if t_len % Q_BLOCK == 0 else t_len
    n_qb = t_len // qb_len
    slopes = alibi_slopes()
    blk = jnp.arange(n_slc)
    b_ix = jnp.arange(bsz)[:, None, None, None]
    g_ix = jnp.arange(N_KV)[None, :, None, None]

    def attend_block(args):
        qb, gb, t0 = args
        t = p_len + t0 + jnp.arange(qb_len)
        tf = t.astype(jnp.float32)
        s_c = jnp.einsum('bqghd,bngd->bghqn', qb, k_c, preferred_element_type=jnp.float32)
        s_c = s_c - slopes[:, :, None, None] * (tf[:, None] - cmp_end[None, :].astype(jnp.float32))
        p_c = masked_softmax(s_c, cmp_end[None, :] <= t[:, None])
        o_c = jnp.einsum('bghqn,bngd->bqghd', p_c.astype(dt), v_c)
        imp = jnp.pad(p_c.sum(axis=2), ((0, 0), (0, 0), (0, 0), (0, n_slc * CMP_PER_SLC - n_cmp)))
        imp = imp.reshape(bsz, N_KV, qb_len, n_slc, CMP_PER_SLC).sum(-1)
        cur = (t // SLC_BLOCK)[:, None]
        forced = (blk == 0) | ((blk <= cur) & (blk > cur - N_LOCAL))
        score = jnp.where(forced, FORCE, jnp.where(blk <= cur, imp, NEG_INF))
        _, idx = lax.top_k(score, n_sel)
        k_s = k_sl[b_ix, g_ix, idx].reshape(bsz, N_KV, qb_len, n_sel * SLC_BLOCK, HEAD_DIM)
        v_s = v_sl[b_ix, g_ix, idx].reshape(bsz, N_KV, qb_len, n_sel * SLC_BLOCK, HEAD_DIM)
        pos_s = (idx[..., None] * SLC_BLOCK + jnp.arange(SLC_BLOCK)).reshape(bsz, N_KV, qb_len, n_sel * SLC_BLOCK)
        s_s = jnp.einsum('bqghd,bgqsd->bghqs', qb, k_s, preferred_element_type=jnp.float32)
        s_s = s_s - slopes[None, :, :, None, None] * (tf[:, None] - pos_s.astype(jnp.float32))[:, :, None]
        p_s = masked_softmax(s_s, (pos_s <= t[:, None])[:, :, None])
        o_s = jnp.einsum('bghqs,bgqsd->bqghd', p_s.astype(dt), v_s)
        kw = lax.dynamic_slice_in_dim(win, t0, WINDOW + qb_len, axis=1)
        pos_w = p_len - WINDOW + t0 + jnp.arange(WINDOW + qb_len)
        dist = t[:, None] - pos_w[None, :]
        valid_w = (pos_w[None, :] >= 0) & (dist >= 0) & (dist < WINDOW)
        s_w = jnp.einsum('bqghd,bsgd->bghqs', qb, kw[:, :, 0], preferred_element_type=jnp.float32)
        s_w = s_w - slopes[:, :, None, None] * dist.astype(jnp.float32)
        p_w = masked_softmax(s_w, valid_w)
        o_w = jnp.einsum('bghqs,bsgd->bqghd', p_w.astype(dt), kw[:, :, 1])
        g = gb[..., None].astype(dt)
        return g[:, :, 0] * o_c + g[:, :, 1] * o_s + g[:, :, 2] * o_w

    q_blocks = q.reshape(bsz, n_qb, qb_len, N_KV, HPG, HEAD_DIM).transpose(1, 0, 2, 3, 4, 5)
    g_blocks = gates.reshape(bsz, n_qb, qb_len, 3, N_KV, HPG).transpose(1, 0, 2, 3, 4, 5)
    starts = jnp.arange(n_qb, dtype=jnp.int32) * qb_len
    o = lax.map(attend_block, (q_blocks, g_blocks, starts))
    o = o.transpose(1, 0, 2, 3, 4, 5).reshape(bsz, t_len, D_ATT)
    y = (o * jax.nn.silu(z)) @ w_out

    all_win = jnp.concatenate([win_buf.astype(dt), win_new], axis=1)
    keep = win_buf.shape[1] if p_len > 0 else min(WINDOW, t_len)
    return y, rows, all_win[:, all_win.shape[1] - keep:]


def setup_inputs(seed: int = 0) -> dict:
    key = jax.random.key(seed)
    ks = jax.random.split(key, 32)
    f32 = jnp.float32

    def nrm(k, shape, scale):
        return jax.random.normal(k, shape, f32) * scale

    n_pages = PAST_LEN // PAGE_SIZE
    n_used = DEC_BATCH * n_pages
    n_pool = n_used + max(1, n_used // 4)
    win_rows = min(WINDOW, PAST_LEN)
    page_table = jax.random.permutation(ks[7], n_pool)[:n_used].reshape(DEC_BATCH, n_pages).astype(jnp.int32)
    a0 = jax.random.uniform(ks[23], (N_LAYERS_C, D_RNN), f32, 0.9, 0.999)
    s0 = a0 ** (1.0 / RG_C)
    d_bin = D_ATT + 6 * N_KV * HEAD_DIM + 3 * N_HEADS + D_ATT
    return {
        'x_prompt': nrm(ks[0], (BATCH, SEQ, D_MODEL), 1.0),
        'x_sample': nrm(ks[1], (DEC_BATCH, DEC_SEQ, D_MODEL), 1.0),
        'cache_nsa_kv': nrm(ks[2], (N_LAYERS_B, n_pool, PAGE_SIZE, 4, N_KV, HEAD_DIM), 1.0),
        'cache_nsa_win': nrm(ks[3], (N_LAYERS_B, DEC_BATCH, win_rows, 2, N_KV, HEAD_DIM), 1.0),
        'state_conv_a': nrm(ks[4], (N_LAYERS_A, DEC_BATCH, CONV_A_WIDTH - 1, D_CONV), 1.0),
        'state_lru_h': nrm(ks[5], (N_LAYERS_C, DEC_BATCH, D_RNN), 0.5),
        'state_lru_conv': nrm(ks[6], (N_LAYERS_C, DEC_BATCH, CONV_C_WIDTH - 1, D_RNN), 1.0),
        'page_table': page_table,
        'ln_g': 1.0 + nrm(ks[8], (DEPTH, D_MODEL), 0.02),
        'ln_b': nrm(ks[9], (DEPTH, D_MODEL), 0.02),
        'a_w_in': nrm(ks[10], (N_LAYERS_A, D_MODEL, 4 * D_CONV), D_MODEL ** -0.5),
        'a_conv_w': nrm(ks[11], (N_LAYERS_A, CONV_A_WIDTH, D_CONV), CONV_A_WIDTH ** -0.5),
        'a_w_out': nrm(ks[12], (N_LAYERS_A, D_CONV, D_MODEL), BETA * D_CONV ** -0.5),
        'b_w_in': nrm(ks[13], (N_LAYERS_B, D_MODEL, d_bin), D_MODEL ** -0.5),
        'b_w_cmp': (1.0 + nrm(ks[14], (N_LAYERS_B, 2, CMP_BLOCK, N_KV, HEAD_DIM), 0.1)) * CMP_BLOCK ** -0.5,
        'b_w_out': nrm(ks[15], (N_LAYERS_B, D_ATT, D_MODEL), BETA * D_ATT ** -0.5),
        'c_w_in': nrm(ks[16], (N_LAYERS_C, D_MODEL, 2 * D_RNN), D_MODEL ** -0.5),
        'c_conv_w': nrm(ks[17], (N_LAYERS_C, CONV_C_WIDTH, D_RNN), CONV_C_WIDTH ** -0.5),
        'c_conv_b': nrm(ks[18], (N_LAYERS_C, D_RNN), 0.02),
        'c_w_a': nrm(ks[19], (N_LAYERS_C, N_RG_BLOCKS, RG_BLOCK, RG_BLOCK), RG_BLOCK ** -0.5),
        'c_b_a': nrm(ks[20], (N_LAYERS_C, D_RNN), 0.02),
        'c_w_x': nrm(ks[21], (N_LAYERS_C, N_RG_BLOCKS, RG_BLOCK, RG_BLOCK), RG_BLOCK ** -0.5),
        'c_b_x': nrm(ks[22], (N_LAYERS_C, D_RNN), 0.02),
        'c_lam': jnp.log(s0) - jnp.log1p(-s0),
        'c_w_out': nrm(ks[24], (N_LAYERS_C, D_RNN, D_MODEL), BETA * D_RNN ** -0.5),
    }


def reference(x_prompt, x_sample, cache_nsa_kv, cache_nsa_win, state_conv_a, state_lru_h, state_lru_conv, page_table,
              ln_g, ln_b, a_w_in, a_conv_w, a_w_out, b_w_in, b_w_cmp, b_w_out,
              c_w_in, c_conv_w, c_conv_b, c_w_a, c_b_a, c_w_x, c_b_x, c_lam, c_w_out):
    yp, ys = x_prompt, x_sample
    bp, bs = x_prompt.shape[0], x_sample.shape[0]
    dt = x_prompt.dtype
    n_pages = page_table.shape[1]
    conv_a_p, conv_a_s = [], []
    rows_p, rows_s, win_p, win_s = [], [], [], []
    h_p, h_s, cc_p, cc_s = [], [], [], []
    for i in range(DEPTH):
        kind, j = i % N_MIXERS, i // N_MIXERS
        if kind == 0:
            mp, sp = short_conv_mixer(yp, jnp.zeros((bp, CONV_A_WIDTH - 1, D_CONV), dt), a_w_in[j], a_conv_w[j], a_w_out[j])
            ms, ss = short_conv_mixer(ys, state_conv_a[j], a_w_in[j], a_conv_w[j], a_w_out[j])
            conv_a_p.append(sp)
            conv_a_s.append(ss)
        elif kind == 1:
            past = cache_nsa_kv[j][page_table].reshape(bs, n_pages * PAGE_SIZE, 4, N_KV, HEAD_DIM)
            mp, rp, wp = nsa_mixer(yp, jnp.zeros((bp, 0, 4, N_KV, HEAD_DIM), dt), jnp.zeros((bp, 0, 2, N_KV, HEAD_DIM), dt),
                                   b_w_in[j], b_w_cmp[j], b_w_out[j])
            ms, rs, ws = nsa_mixer(ys, past, cache_nsa_win[j], b_w_in[j], b_w_cmp[j], b_w_out[j])
            rows_p.append(rp)
            rows_s.append(rs)
            win_p.append(wp)
            win_s.append(ws)
        else:
            mp, hp, cp = rglru_mixer(yp, jnp.zeros((bp, D_RNN), dt), jnp.zeros((bp, CONV_C_WIDTH - 1, D_RNN), dt),
                                     c_w_in[j], c_conv_w[j], c_conv_b[j], c_w_a[j], c_b_a[j], c_w_x[j], c_b_x[j], c_lam[j], c_w_out[j])
            ms, hs, cs = rglru_mixer(ys, state_lru_h[j], state_lru_conv[j],
                                     c_w_in[j], c_conv_w[j], c_conv_b[j], c_w_a[j], c_b_a[j], c_w_x[j], c_b_x[j], c_lam[j], c_w_out[j])
            h_p.append(hp)
            h_s.append(hs)
            cc_p.append(cp)
            cc_s.append(cs)
        yp = layer_norm(ALPHA * yp + mp, ln_g[i], ln_b[i])
        ys = layer_norm(ALPHA * ys + ms, ln_g[i], ln_b[i])
    return (yp, ys, jnp.stack(conv_a_p), jnp.stack(conv_a_s), jnp.stack(rows_p), jnp.stack(rows_s),
            jnp.stack(win_p), jnp.stack(win_s), jnp.stack(h_p), jnp.stack(h_s), jnp.stack(cc_p), jnp.stack(cc_s))
```

```cpp
#include <hip/hip_runtime.h>
#include <cstdio>
#include <cstdint>

#ifndef MK_ONE_LAUNCH
#define MK_ONE_LAUNCH 1
#endif

typedef _Float16 f16;
typedef _Float16 f16x8 __attribute__((ext_vector_type(8)));
typedef _Float16 f16x4 __attribute__((ext_vector_type(4)));
typedef float f32x4 __attribute__((ext_vector_type(4)));
typedef unsigned u32x4 __attribute__((ext_vector_type(4)));
#define LAS __attribute__((address_space(3)))

constexpr int D = 1024, BATCH = 8, SEQ = 2048, DEC_B = 32, DEC_T = 4, PAST = 8192, PAGE = 128, NPAGES = PAST / PAGE;
constexpr int MP = BATCH * SEQ, MS = DEC_B * DEC_T, MT = MP + MS;
constexpr int NBIN = 2864, NBIN_PAD = 3072;
constexpr float ALPHA = 1.681792830507429f, LN_EPS = 1e-5f;
constexpr int NWAVES = 8, NTHREADS = 512;
constexpr int LDS_BYTES = 147456;

constexpr size_t O_YP = 0, O_YS = 16777216, O_CAP = 16908288, O_CAS = 16941056, O_RP = 17072128, O_RS = 25460736,
                 O_WP = 25526272, O_WS = 26574848, O_HP = 30769152, O_HS = 30777344, O_CP = 30810112, O_CS = 30834688, O_END = 30932992;

constexpr size_t MiB = 1u << 20;
constexpr size_t WS_CTL = 0, CTL_BYTES = 1 * MiB;
constexpr size_t WS_WA_IN0 = 2 * MiB, WS_WA_IN1 = 10 * MiB, WS_WA_OUT0 = 18 * MiB, WS_WA_OUT1 = 20 * MiB, WS_WB_IN = 22 * MiB, WS_WB_OUT = 28 * MiB,
                 WS_WC_IN = 30 * MiB, WS_WC_G = 34 * MiB, WS_WC_OUT = 35 * MiB;
constexpr size_t WS_XA = 40 * MiB, WS_V32 = 74 * MiB, WS_U16 = 142 * MiB, WS_A2 = 278 * MiB, WS_Q16 = 312 * MiB, WS_SZ16 = 346 * MiB, WS_OG = 380 * MiB,
                 WS_KV32 = 414 * MiB, WS_GATES = 466 * MiB, WS_KVCP = 470 * MiB, WS_KVCS = 471 * MiB, WS_U16C = 479 * MiB, WS_UC16 = 513 * MiB,
                 WS_UC32 = 547 * MiB, WS_RI32 = 615 * MiB, WS_YH = 751 * MiB, WS_END = 785 * MiB;

struct Args { const void* in[25]; float* out; unsigned char* ws; int ph_lo, ph_hi; };

__device__ __forceinline__ float sigmoidf_(float x) { return 1.f / (1.f + __expf(-x)); }
__device__ __forceinline__ float siluf_(float x) { return x / (1.f + __expf(-x)); }
__device__ __forceinline__ float wave_sum(float v) {
#pragma unroll
    for (int o = 1; o < 64; o <<= 1) v += __shfl_xor(v, o);
    return v;
}
__device__ __forceinline__ float wave_max(float v) {
#pragma unroll
    for (int o = 1; o < 64; o <<= 1) v = fmaxf(v, __shfl_xor(v, o));
    return v;
}

#define XB_TMO      128
#define XB_XCNT(j)  (256  + 64 * (j))
#define XB_XSUB(j)  (1280 + 64 * (j))
#define XB_XGEN(j)  (2304 + 64 * (j))
#define XB_TOP      3328
#define XB_TOPGEN   3392
#define XCD_BAR_WORDS 3456
#define XB_SPIN_CAP (1u << 22)
__device__ __forceinline__ unsigned xb_ld(unsigned* p)              { return __hip_atomic_load(p, __ATOMIC_RELAXED, __HIP_MEMORY_SCOPE_AGENT); }
__device__ __forceinline__ unsigned xb_add(unsigned* p, unsigned v) { return __hip_atomic_fetch_add(p, v, __ATOMIC_RELAXED, __HIP_MEMORY_SCOPE_AGENT); }
__device__ __forceinline__ unsigned xb_xcc_id() { return (unsigned)__builtin_amdgcn_s_getreg((3 << 11) | 20) & 0xFu; }
#define XB_SPIN(cond, bar) do { unsigned _sp = 0; while (cond) { __builtin_amdgcn_s_sleep(1); \
    if ((++_sp & 255u) == 0u) { if (xb_ld(&(bar)[XB_TMO])) break; if (_sp > XB_SPIN_CAP) { atomicAdd(&(bar)[XB_TMO], 1u); break; } } } } while (0)
struct XcdBarrier { unsigned* bar; unsigned x; volatile LAS unsigned* st; };
__device__ __forceinline__ XcdBarrier xcd_barrier_post(unsigned* bar, volatile LAS unsigned* st) {
    XcdBarrier b; b.bar = bar; b.x = xb_xcc_id(); b.st = st;
    if (threadIdx.x == 0) (void)xb_add(&bar[XB_XCNT(b.x)], 1u);
    return b;
}
__device__ __forceinline__ void xcd_barrier_complete(unsigned* bar, unsigned x, unsigned& nloc, unsigned& nx) {
    const unsigned G = gridDim.x * gridDim.y * gridDim.z;
    unsigned sum, cnt, mine, sp = 0u;
    for (;;) {
        sum = 0u; cnt = 0u; mine = 0u;
#pragma unroll
        for (unsigned j = 0; j < 16; ++j) { const unsigned c = xb_ld(&bar[XB_XCNT(j)]); sum += c; cnt += (c > 0u) ? 1u : 0u; mine = (j == x) ? c : mine; }
        if (sum == G) break;
        __builtin_amdgcn_s_sleep(1);
        if ((++sp & 255u) == 0u) { if (xb_ld(&bar[XB_TMO])) break; if (sp > XB_SPIN_CAP) { atomicAdd(&bar[XB_TMO], 1u); break; } }
    }
    nloc = mine > 0u ? mine : 1u; nx = cnt > 0u ? cnt : 1u;
}
__device__ __forceinline__ void xcd_barrier(const XcdBarrier& b) {
    asm volatile("s_waitcnt vmcnt(0)" ::: "memory");
    __syncthreads();
    if (threadIdx.x == 0) {
        unsigned* bar = b.bar;
        __builtin_amdgcn_s_waitcnt(0);
        unsigned nloc = b.st[0], nx = b.st[1];
        if (nloc == 0u) { xcd_barrier_complete(bar, b.x, nloc, nx); b.st[0] = nloc; b.st[1] = nx; }
        const unsigned old = xb_add(&bar[XB_XSUB(b.x)], 1u);
        const unsigned gen = old / nloc;
        if (old + 1u == (gen + 1u) * nloc) {
            __builtin_amdgcn_fence(__ATOMIC_RELEASE, "agent");
            asm volatile("s_waitcnt vmcnt(0)" ::: "memory");
            const unsigned og = xb_add(&bar[XB_TOP], 1u);
            const unsigned tg = og / nx;
            if (og + 1u == (tg + 1u) * nx) xb_add(&bar[XB_TOPGEN], 1u);
            else XB_SPIN(xb_ld(&bar[XB_TOPGEN]) == tg, bar);
            __builtin_amdgcn_fence(__ATOMIC_ACQUIRE, "agent");
            xb_add(&bar[XB_XGEN(b.x)], 1u);
            asm volatile("s_waitcnt vmcnt(0)" ::: "memory");
        } else {
            XB_SPIN(xb_ld(&bar[XB_XGEN(b.x)]) == gen, bar);
            __builtin_amdgcn_fence(__ATOMIC_ACQUIRE, "agent");
            asm volatile("s_waitcnt vmcnt(0)" ::: "memory");
        }
    }
    __syncthreads();
}

struct Frame {
    LAS unsigned char* lds;
    int tid, lane, wave, bid, nb;
    const Args* ap;
    float* out; unsigned char* ws;
};
#define INF(k) ((const float*)F.ap->in[k])
#define WSP(T, off) ((T*)(F.ws + (off)))

__device__ __forceinline__ void transpose_item(const float* W, int K, int N, f16* WT, int row_off, LAS float* scr, int item, int lane, int nblk) {
    const int kb = item / nblk, nb = item % nblk, k0 = 64 * kb, n0 = 32 * nb;
#pragma unroll 8
    for (int i = 0; i < 32; ++i) { const int kk = 2 * i + (lane >> 5); const int n = n0 + (lane & 31); scr[kk * 33 + (lane & 31)] = (n < N) ? W[(size_t)(k0 + kk) * N + n] : 0.f; }
    asm volatile("s_waitcnt lgkmcnt(0)" ::: "memory");
    const int c = lane & 7;
#pragma unroll
    for (int j = 0; j < 4; ++j) { const int n = (lane >> 3) + 8 * j; const LAS float* s = scr + (8 * c) * 33 + n;
        f16x8 o; o[0] = (f16)s[0 * 33]; o[1] = (f16)s[1 * 33]; o[2] = (f16)s[2 * 33]; o[3] = (f16)s[3 * 33]; o[4] = (f16)s[4 * 33]; o[5] = (f16)s[5 * 33]; o[6] = (f16)s[6 * 33]; o[7] = (f16)s[7 * 33];
        *(f16x8*)(WT + (size_t)(row_off + n0 + n) * K + k0 + 8 * c) = o; }
    asm volatile("s_waitcnt lgkmcnt(0)" ::: "memory");
}
__device__ __forceinline__ void phase_prep(Frame& F) {
    LAS float* scr = (LAS float*)(F.lds + F.wave * 16384);
    const int gw = F.bid * NWAVES + F.wave, NGW = F.nb * NWAVES;
    constexpr int I_AIN = 16 * 128, I_SQ = 16 * 32, I_BIN = 16 * 96, I_CIN = 16 * 64, I_G = 4 * 8;
    constexpr int NITEMS = 2 * I_AIN + 2 * I_SQ + I_BIN + I_SQ + I_CIN + 8 * I_G + I_SQ;
    for (int it = gw; it < NITEMS; it += NGW) {
        int r = it;
        if (r < I_AIN) { transpose_item(INF(10), D, 4096, WSP(f16, WS_WA_IN0), 0, scr, r, F.lane, 128); continue; } r -= I_AIN;
        if (r < I_AIN) { transpose_item(INF(10) + (size_t)D * 4096, D, 4096, WSP(f16, WS_WA_IN1), 0, scr, r, F.lane, 128); continue; } r -= I_AIN;
        if (r < I_SQ) { transpose_item(INF(12), D, D, WSP(f16, WS_WA_OUT0), 0, scr, r, F.lane, 32); continue; } r -= I_SQ;
        if (r < I_SQ) { transpose_item(INF(12) + (size_t)D * D, D, D, WSP(f16, WS_WA_OUT1), 0, scr, r, F.lane, 32); continue; } r -= I_SQ;
        if (r < I_BIN) { transpose_item(INF(13), D, NBIN, WSP(f16, WS_WB_IN), 0, scr, r, F.lane, 96); continue; } r -= I_BIN;
        if (r < I_SQ) { transpose_item(INF(15), D, D, WSP(f16, WS_WB_OUT), 0, scr, r, F.lane, 32); continue; } r -= I_SQ;
        if (r < I_CIN) { transpose_item(INF(16), D, 2048, WSP(f16, WS_WC_IN), 0, scr, r, F.lane, 64); continue; } r -= I_CIN;
        if (r < 8 * I_G) { const int blk = r / I_G, ri = r % I_G;
            const float* src = (blk < 4 ? INF(19) : INF(21)) + (size_t)(blk & 3) * 256 * 256;
            transpose_item(src, 256, 256, WSP(f16, WS_WC_G), blk * 256, scr, ri, F.lane, 8); continue; } r -= 8 * I_G;
        transpose_item(INF(24), D, D, WSP(f16, WS_WC_OUT), 0, scr, r, F.lane, 32);
    }
    const int gt = F.bid * NTHREADS + F.tid, NGT = F.nb * NTHREADS;
    f16* XA = WSP(f16, WS_XA);
    for (int i = gt; i < MT * 128; i += NGT) {
        const int row = i >> 7, c8 = (i & 127) * 8;
        const float* src = (row < MP) ? INF(0) + (size_t)row * D + c8 : INF(1) + (size_t)(row - MP) * D + c8;
        const f32x4 a = *(const f32x4*)src, b = *(const f32x4*)(src + 4);
        f16x8 o; o[0] = (f16)a[0]; o[1] = (f16)a[1]; o[2] = (f16)a[2]; o[3] = (f16)a[3]; o[4] = (f16)b[0]; o[5] = (f16)b[1]; o[6] = (f16)b[2]; o[7] = (f16)b[3];
        *(f16x8*)(XA + (size_t)row * D + c8) = o;
    }
    float* KVCS = WSP(float, WS_KVCS);
    for (int it = gw; it < DEC_B * 256; it += NGW) {
        const int b = it >> 8, n = it & 255;
        const int page = ((const int*)F.ap->in[7])[b * NPAGES + (n >> 2)];
        const float* src = INF(2) + ((size_t)page * PAGE + (n & 3) * 32) * 512 + F.lane * 4;
        const int f = F.lane * 4;
        const float* w = INF(14) + (f >> 7) * 4096 + (f & 127);
        f32x4 acc = {0.f, 0.f, 0.f, 0.f};
#pragma unroll 8
        for (int j = 0; j < 32; ++j) { const f32x4 v = *(const f32x4*)(src + (size_t)j * 512); const f32x4 ww = *(const f32x4*)(w + j * 128); acc += v * ww; }
        *(f32x4*)(KVCS + (size_t)it * 256 + f) = acc;
    }
    for (int i = gt; i < DEC_B * 508 * 64; i += NGT) {
        const int b = i / (508 * 64), r = i % (508 * 64);
        *(f32x4*)(F.out + O_WS + (size_t)b * 512 * 256 + (size_t)r * 4) = *(const f32x4*)(INF(3) + (size_t)b * 512 * 256 + 4 * 256 + (size_t)r * 4);
    }
}

template <int MTL, int NTL>
__device__ __forceinline__ void wave_gemm(const f16* A, int lda, const f16* Bt, int ldb, int K, int row0, int col0, int lane, f32x4 (&acc)[MTL][NTL]) {
    const int fr = lane & 15, fq = lane >> 4;
    const f16* ap = A + (size_t)(row0 + fr) * lda + 8 * fq;
    const f16* bp = Bt + (size_t)(col0 + fr) * ldb + 8 * fq;
    for (int k = 0; k < K; k += 32) {
        f16x8 a[MTL], b[NTL];
#pragma unroll
        for (int m = 0; m < MTL; ++m) a[m] = *(const f16x8*)(ap + (size_t)m * 16 * lda + k);
#pragma unroll
        for (int n = 0; n < NTL; ++n) b[n] = *(const f16x8*)(bp + (size_t)n * 16 * ldb + k);
#pragma unroll
        for (int m = 0; m < MTL; ++m)
#pragma unroll
            for (int n = 0; n < NTL; ++n) acc[m][n] = __builtin_amdgcn_mfma_f32_16x16x32_f16(b[n], a[m], acc[m][n], 0, 0, 0);
    }
}
template <class Epi>
__device__ __forceinline__ void gemm_naive(Frame& F, const f16* A, int lda, const f16* Bt, int ldb, int M, int N, int K, int acolmode, const Epi& E) {
    const int nM = M / 128, nN = N / 256, nit = nM * nN;
    const int wr = F.wave >> 2, wc = F.wave & 3, fr = F.lane & 15, fq = F.lane >> 4;
    for (int it = F.bid; it < nit; it += F.nb) {
        const int tm = it / nN, tn = it % nN;
        const int row0 = tm * 128 + wr * 64, col0 = tn * 256 + wc * 64;
        f32x4 acc[4][4];
#pragma unroll
        for (int m = 0; m < 4; ++m)
#pragma unroll
            for (int n = 0; n < 4; ++n) acc[m][n] = (f32x4){0.f, 0.f, 0.f, 0.f};
        const int acol = acolmode ? ((col0 & 1023) >> 8) * 256 : 0;
        wave_gemm<4, 4>(A + acol, lda, Bt, ldb, K, row0, col0, F.lane, acc);
#pragma unroll
        for (int m = 0; m < 4; ++m)
#pragma unroll
            for (int n = 0; n < 4; ++n) E(row0 + 16 * m + fr, col0 + 16 * n + 4 * fq, acc[m][n]);
    }
}
struct EpiStoreF16 { f16* O; int ldo; int ncols;
    __device__ __forceinline__ void operator()(int row, int col, f32x4 v) const { if (col < ncols) { f16x4 o; o[0] = (f16)v[0]; o[1] = (f16)v[1]; o[2] = (f16)v[2]; o[3] = (f16)v[3]; *(f16x4*)(O + (size_t)row * ldo + col) = o; } } };
struct EpiStoreF32 { float* O; int ldo;
    __device__ __forceinline__ void operator()(int row, int col, f32x4 v) const { *(f32x4*)(O + (size_t)row * ldo + col) = v; } };
struct EpiResid { const f16* X; float* V;
    __device__ __forceinline__ void operator()(int row, int col, f32x4 v) const { const f16x4 x = *(const f16x4*)(X + (size_t)row * D + col);
        f32x4 o; o[0] = ALPHA * (float)x[0] + v[0]; o[1] = ALPHA * (float)x[1] + v[1]; o[2] = ALPHA * (float)x[2] + v[2]; o[3] = ALPHA * (float)x[3] + v[3]; *(f32x4*)(V + (size_t)row * D + col) = o; } };
struct EpiNsaProj { f16* Q; float* KV; float* G; f16* SZ; float* out;
    __device__ __forceinline__ void operator()(int row, int col, f32x4 v) const {
        if (col < 1024) { f16x4 o; o[0] = (f16)(v[0] * 0.125f); o[1] = (f16)(v[1] * 0.125f); o[2] = (f16)(v[2] * 0.125f); o[3] = (f16)(v[3] * 0.125f); *(f16x4*)(Q + (size_t)row * D + col) = o; }
        else if (col < 1792) { const int c = col - 1024; *(f32x4*)(KV + (size_t)row * 768 + c) = v;
            if (c < 512) { if (row < MP) *(f32x4*)(out + O_RP + (size_t)row * 512 + c) = v; else *(f32x4*)(out + O_RS + (size_t)(row - MP) * 512 + c) = v; }
            else { const int cw = c - 512;
                if (row < MP) { const int b = row >> 11, t = row & 2047; if (t >= 1536) *(f32x4*)(out + O_WP + ((size_t)b * 512 + (t - 1536)) * 256 + cw) = v; }
                else { const int s = row - MP, b = s >> 2, t = s & 3; *(f32x4*)(out + O_WS + ((size_t)b * 512 + 508 + t) * 256 + cw) = v; } } }
        else if (col < 1840) { f32x4 o; o[0] = sigmoidf_(v[0]); o[1] = sigmoidf_(v[1]); o[2] = sigmoidf_(v[2]); o[3] = sigmoidf_(v[3]); *(f32x4*)(G + (size_t)row * 48 + (col - 1792)) = o; }
        else if (col < 2864) { f16x4 o; o[0] = (f16)siluf_(v[0]); o[1] = (f16)siluf_(v[1]); o[2] = (f16)siluf_(v[2]); o[3] = (f16)siluf_(v[3]); *(f16x4*)(SZ + (size_t)row * D + (col - 1840)) = o; }
    } };
struct EpiLruIn { f16* U; f16* SZ; float* out;
    __device__ __forceinline__ void operator()(int row, int col, f32x4 v) const {
        if (col < 1024) { f16x4 o; o[0] = (f16)v[0]; o[1] = (f16)v[1]; o[2] = (f16)v[2]; o[3] = (f16)v[3]; *(f16x4*)(U + (size_t)row * D + col) = o;
            if (row < MP) { const int b = row >> 11, t = row & 2047; if (t >= 2045) *(f32x4*)(out + O_CP + ((size_t)b * 3 + (t - 2045)) * D + col) = v; }
            else { const int s = row - MP, b = s >> 2, t = s & 3; if (t >= 1) *(f32x4*)(out + O_CS + ((size_t)b * 3 + (t - 1)) * D + col) = v; } }
        else { f16x4 o; o[0] = (f16)siluf_(v[0]); o[1] = (f16)siluf_(v[1]); o[2] = (f16)siluf_(v[2]); o[3] = (f16)siluf_(v[3]); *(f16x4*)(SZ + (size_t)row * D + (col - 1024)) = o; }
    } };

__device__ __forceinline__ void phase_convgate(Frame& F, int j) {
    const f16* U = WSP(f16, WS_U16); f16* A2 = WSP(f16, WS_A2);
    const float* cw = INF(11) + (size_t)j * 3 * D;
    const int gt = F.bid * NTHREADS + F.tid, NGT = F.nb * NTHREADS;
    for (int i = gt; i < MT * 128; i += NGT) {
        const int row = i >> 7, c8 = (i & 127) * 8;
        int t, b; bool samp = row >= MP;
        if (!samp) { b = row >> 11; t = row & 2047; } else { const int s = row - MP; b = s >> 2; t = s & 3; }
        float u[3][8];
#pragma unroll
        for (int k = 0; k < 3; ++k) {
            const int tt = t - 2 + k;
            if (tt >= 0) { const f16x8 h = *(const f16x8*)(U + (size_t)(row - 2 + k) * 4096 + c8), c = *(const f16x8*)(U + (size_t)(row - 2 + k) * 4096 + 2048 + c8);
#pragma unroll
                for (int e = 0; e < 8; ++e) u[k][e] = (float)c[e] * (float)h[e]; }
            else if (samp) { const float* st = INF(4) + (((size_t)j * DEC_B + b) * 2 + (2 + tt)) * D + c8;
#pragma unroll
                for (int e = 0; e < 8; ++e) u[k][e] = st[e]; }
            else {
#pragma unroll
                for (int e = 0; e < 8; ++e) u[k][e] = 0.f; }
        }
        const f16x8 bg = *(const f16x8*)(U + (size_t)row * 4096 + 1024 + c8), z = *(const f16x8*)(U + (size_t)row * 4096 + 3072 + c8);
        f16x8 o;
#pragma unroll
        for (int e = 0; e < 8; ++e) { const float conv = cw[c8 + e] * u[0][e] + cw[D + c8 + e] * u[1][e] + cw[2 * D + c8 + e] * u[2][e];
            o[e] = (f16)(siluf_((float)z[e]) * (float)bg[e] * conv); }
        *(f16x8*)(A2 + (size_t)row * D + c8) = o;
        if (!samp && t >= 2046) { float* dst = F.out + O_CAP + (((size_t)j * BATCH + b) * 2 + (t - 2046)) * D + c8;
#pragma unroll
            for (int e = 0; e < 8; ++e) dst[e] = u[2][e]; }
        if (samp && t >= 2) { float* dst = F.out + O_CAS + (((size_t)j * DEC_B + b) * 2 + (t - 2)) * D + c8;
#pragma unroll
            for (int e = 0; e < 8; ++e) dst[e] = u[2][e]; }
    }
}
__device__ __forceinline__ void phase_ln(Frame& F, int li, bool last) {
    const float* V = WSP(float, WS_V32); f16* XA = WSP(f16, WS_XA);
    const float* g = INF(8) + (size_t)li * D; const float* bb = INF(9) + (size_t)li * D;
    const int gw = F.bid * NWAVES + F.wave, NGW = F.nb * NWAVES;
    for (int row = gw; row < MT; row += NGW) {
        const f32x4* vr = (const f32x4*)(V + (size_t)row * D) + F.lane;
        f32x4 v[4]; float s = 0.f;
#pragma unroll
        for (int q = 0; q < 4; ++q) { v[q] = vr[64 * q]; s += (v[q][0] + v[q][1]) + (v[q][2] + v[q][3]); }
        const float mean = wave_sum(s) * (1.f / D); float s2 = 0.f;
#pragma unroll
        for (int q = 0; q < 4; ++q) { v[q] = v[q] - mean; s2 += (v[q][0] * v[q][0] + v[q][1] * v[q][1]) + (v[q][2] * v[q][2] + v[q][3] * v[q][3]); }
        const float rstd = 1.f / sqrtf(wave_sum(s2) * (1.f / D) + LN_EPS);
#pragma unroll
        for (int q = 0; q < 4; ++q) { const int col = 4 * F.lane + 256 * q; const f32x4 gg = *(const f32x4*)(g + col), be = *(const f32x4*)(bb + col);
            const f32x4 y = v[q] * rstd * gg + be;
            f16x4 o; o[0] = (f16)y[0]; o[1] = (f16)y[1]; o[2] = (f16)y[2]; o[3] = (f16)y[3]; *(f16x4*)(XA + (size_t)row * D + col) = o;
            if (last) { float* dst = (row < MP) ? F.out + O_YP + (size_t)row * D + col : F.out + O_YS + (size_t)(row - MP) * D + col; *(f32x4*)dst = y; } }
    }
}
__device__ __forceinline__ void phase_compress_prompt(Frame& F) {
    const float* KV = WSP(float, WS_KV32); float* KVCP = WSP(float, WS_KVCP);
    const int gw = F.bid * NWAVES + F.wave, NGW = F.nb * NWAVES;
    for (int it = gw; it < BATCH * 64; it += NGW) {
        const int b = it >> 6, n = it & 63; const int f = F.lane * 4;
        const float* src = KV + ((size_t)b * SEQ + n * 32) * 768 + f; const float* w = INF(14) + (f >> 7) * 4096 + (f & 127);
        f32x4 acc = {0.f, 0.f, 0.f, 0.f};
#pragma unroll 8
        for (int j = 0; j < 32; ++j) acc += *(const f32x4*)(src + (size_t)j * 768) * *(const f32x4*)(w + j * 128);
        *(f32x4*)(KVCP + (size_t)it * 256 + f) = acc;
    }
}
__device__ __forceinline__ void phase_conv4(Frame& F) {
    const f16* U = WSP(f16, WS_U16C); f16* UC16 = WSP(f16, WS_UC16); float* UC32 = WSP(float, WS_UC32);
    const int gt = F.bid * NTHREADS + F.tid, NGT = F.nb * NTHREADS;
    for (int i = gt; i < MT * 128; i += NGT) {
        const int row = i >> 7, c8 = (i & 127) * 8;
        int t, b; bool samp = row >= MP;
        if (!samp) { b = row >> 11; t = row & 2047; } else { const int s = row - MP; b = s >> 2; t = s & 3; }
        float acc[8];
#pragma unroll
        for (int e = 0; e < 8; ++e) acc[e] = INF(18)[c8 + e];
#pragma unroll
        for (int k = 0; k < 4; ++k) {
            const int tt = t - 3 + k; const float* w = INF(17) + (size_t)k * D + c8;
            if (tt >= 0) { const f16x8 u = *(const f16x8*)(U + (size_t)(row - 3 + k) * D + c8);
#pragma unroll
                for (int e = 0; e < 8; ++e) acc[e] += w[e] * (float)u[e]; }
            else if (samp) { const float* st = INF(6) + ((size_t)b * 3 + (3 + tt)) * D + c8;
#pragma unroll
                for (int e = 0; e < 8; ++e) acc[e] += w[e] * st[e]; }
        }
        f16x8 o;
#pragma unroll
        for (int e = 0; e < 8; ++e) { o[e] = (f16)acc[e]; UC32[(size_t)row * D + c8 + e] = acc[e]; }
        *(f16x8*)(UC16 + (size_t)row * D + c8) = o;
    }
}
__device__ __forceinline__ void phase_scan(Frame& F) {
    const float* RI = WSP(float, WS_RI32); const float* UC = WSP(float, WS_UC32); const f16* SZ = WSP(f16, WS_SZ16); f16* YH = WSP(f16, WS_YH);
    const int gt = F.bid * NTHREADS + F.tid, NGT = F.nb * NTHREADS;
    for (int i = gt; i < (BATCH + DEC_B) * D; i += NGT) {
        const int sq = i >> 10, ch = i & 1023;
        const bool samp = sq >= BATCH; const int b = samp ? sq - BATCH : sq;
        const int T = samp ? DEC_T : SEQ; const size_t r0 = samp ? (size_t)MP + b * DEC_T : (size_t)b * SEQ;
        float h = samp ? INF(5)[(size_t)b * D + ch] : 0.f;
        const float cl = -8.f * log1pf(__expf(-INF(23)[ch])); const float ba = INF(20)[ch], bx = INF(22)[ch];
        for (int t = 0; t < T; ++t) {
            const size_t row = r0 + t;
            const float r = sigmoidf_(RI[row * 2048 + ch] + ba), ig = sigmoidf_(RI[row * 2048 + 1024 + ch] + bx);
            const float la = cl * r, a = __expf(la), bq = sqrtf(-expm1f(2.f * la)) * (ig * UC[row * D + ch]);
            h = a * h + bq;
            YH[row * D + ch] = (f16)((float)SZ[row * D + ch] * h);
        }
        if (samp) F.out[O_HS + (size_t)b * D + ch] = h; else F.out[O_HP + (size_t)b * D + ch] = h;
    }
}

struct KeyRef { const float* k; const float* v; int pos; bool valid; };
constexpr int AT_QS = 0, AT_SC = AT_QS + 8 * 64 * 4, AT_PC = AT_SC + 8 * 1088 * 4, AT_IMP = AT_PC + 8 * 264 * 4, AT_SEL = AT_IMP + 136 * 4, AT_END = AT_SEL + 64;
template <class KF>
__device__ __forceinline__ float attn_branch(Frame& F, int nkeys, const KF& kf, float slope, int t, LAS const float* qs, LAS float* sc, LAS float* pcout) {
    float mloc = -1e30f;
    for (int j0 = 0; j0 < nkeys; j0 += 64) {
        const int j = j0 + F.lane; float s = -1e30f;
        if (j < nkeys) { const KeyRef kr = kf(j);
            if (kr.valid) { float acc = 0.f;
#pragma unroll
                for (int d4 = 0; d4 < 16; ++d4) { const f32x4 kk = *(const f32x4*)(kr.k + 4 * d4); const f32x4 qq = *(LAS const f32x4*)(qs + 4 * d4); acc += kk[0] * qq[0] + kk[1] * qq[1] + kk[2] * qq[2] + kk[3] * qq[3]; }
                s = acc - slope * (float)(t - kr.pos); }
            sc[j] = s; }
        mloc = fmaxf(mloc, s);
    }
    const float m = wave_max(mloc);
    float lloc = 0.f;
    for (int j0 = 0; j0 < nkeys; j0 += 64) { const int j = j0 + F.lane; if (j < nkeys) { const float s = sc[j]; const float p = (s > -1e29f) ? __expf(s - m) : 0.f; sc[j] = p; lloc += p; } }
    const float l = wave_sum(lloc);
    const float inv = (l > 0.f) ? 1.f / l : 0.f;
    if (pcout) for (int j0 = 0; j0 < nkeys; j0 += 64) { const int j = j0 + F.lane; if (j < nkeys) pcout[j] = sc[j] * inv; }
    asm volatile("s_waitcnt lgkmcnt(0)" ::: "memory");
    float o = 0.f;
    for (int j = 0; j < nkeys; ++j) { const float p = sc[j]; if (p != 0.f) { const KeyRef kr = kf(j); o += p * kr.v[F.lane]; } }
    return o * inv;
}
__device__ __forceinline__ void phase_attn(Frame& F) {
    const f16* Q = WSP(f16, WS_Q16); const float* KV = WSP(float, WS_KV32); const float* G = WSP(float, WS_GATES); const f16* SZ = WSP(f16, WS_SZ16); f16* OG = WSP(f16, WS_OG);
    const float* KVCP = WSP(float, WS_KVCP); const float* KVCS = WSP(float, WS_KVCS);
    LAS float* qs = (LAS float*)(F.lds + AT_QS) + F.wave * 64; LAS float* sc = (LAS float*)(F.lds + AT_SC) + F.wave * 1088; LAS float* pc = (LAS float*)(F.lds + AT_PC) + F.wave * 264;
    LAS float* pcall = (LAS float*)(F.lds + AT_PC); LAS float* imp = (LAS float*)(F.lds + AT_IMP); LAS int* sel = (LAS int*)(F.lds + AT_SEL);
    const int hh = F.wave;
    for (int it = F.bid; it < MT * 2; it += F.nb) {
        const int row = it >> 1, g = it & 1, head = g * 8 + hh;
        const bool samp = row >= MP; int b, tq;
        if (!samp) { b = row >> 11; tq = row & 2047; } else { const int s = row - MP; b = s >> 2; tq = s & 3; }
        const int t = samp ? PAST + tq : tq;
        const float slope = exp2f(-0.5f * (float)(head + 1));
        qs[F.lane] = (float)Q[(size_t)row * D + head * 64 + F.lane];
        const int ncmp = samp ? 256 : (t + 1) / 32;
        for (int j = F.lane; j < 264; j += 64) pc[j] = 0.f;
        asm volatile("s_waitcnt lgkmcnt(0)" ::: "memory");
        const float* kvc = samp ? KVCS + (size_t)b * 256 * 256 : KVCP + (size_t)b * 64 * 256;
        auto kf_c = [&](int j) { KeyRef r; r.k = kvc + (size_t)j * 256 + g * 64; r.v = kvc + (size_t)j * 256 + 128 + g * 64; r.pos = 32 * j + 31; r.valid = true; return r; };
        const float o_c = (ncmp > 0) ? attn_branch(F, ncmp, kf_c, slope, t, qs, sc, pc) : 0.f;
        __syncthreads();
        const int nslc = samp ? 129 : 32, cur = t >> 6;
        if (F.tid < nslc) { const int blk = F.tid; float s = 0.f;
#pragma unroll
            for (int h2 = 0; h2 < 8; ++h2) s += pcall[h2 * 264 + 2 * blk] + pcall[h2 * 264 + 2 * blk + 1];
            const bool forced = (blk == 0) || (blk <= cur && blk > cur - 2);
            imp[blk] = forced ? 1e9f : (blk <= cur ? s : -1e30f); }
        __syncthreads();
        if (F.tid < nslc) { const float my = imp[F.tid]; int rank = 0;
            for (int j = 0; j < nslc; ++j) { const float o = imp[j]; rank += (o > my || (o == my && j < F.tid)) ? 1 : 0; }
            if (rank < 16) sel[rank] = F.tid; }
        __syncthreads();
        const int* pt = ((const int*)F.ap->in[7]) + b * NPAGES;
        auto kf_s = [&](int j) { KeyRef r; const int blk = sel[j >> 6]; const int pos = blk * 64 + (j & 63); r.pos = pos; r.valid = pos <= t; r.k = KV; r.v = KV;
            if (r.valid) { if (!samp) { const float* p = KV + ((size_t)b * SEQ + pos) * 768; r.k = p + 256 + g * 64; r.v = p + 384 + g * 64; }
                else if (pos < PAST) { const float* p = INF(2) + ((size_t)pt[pos >> 7] * PAGE + (pos & 127)) * 512; r.k = p + 256 + g * 64; r.v = p + 384 + g * 64; }
                else { const float* p = KV + ((size_t)MP + b * DEC_T + (pos - PAST)) * 768; r.k = p + 256 + g * 64; r.v = p + 384 + g * 64; } }
            return r; };
        const float o_s = attn_branch(F, 1024, kf_s, slope, t, qs, sc, (LAS float*)nullptr);
        auto kf_w = [&](int j) { KeyRef r; r.k = KV; r.v = KV;
            if (!samp) { const int pos = t - 511 + j; r.pos = pos; r.valid = pos >= 0; if (r.valid) { const float* p = KV + ((size_t)b * SEQ + pos) * 768; r.k = p + 512 + g * 64; r.v = p + 640 + g * 64; } }
            else { const int w = tq + 1 + j; r.pos = PAST - 512 + w; r.valid = true;
                if (w < 512) { const float* p = INF(3) + ((size_t)b * 512 + w) * 256; r.k = p + g * 64; r.v = p + 128 + g * 64; }
                else { const float* p = KV + ((size_t)MP + b * DEC_T + (w - 512)) * 768; r.k = p + 512 + g * 64; r.v = p + 640 + g * 64; } }
            return r; };
        const float o_w = attn_branch(F, 512, kf_w, slope, t, qs, sc, (LAS float*)nullptr);
        const float* gr = G + (size_t)row * 48 + g * 8 + hh;
        const float o = gr[0] * o_c + gr[16] * o_s + gr[32] * o_w;
        OG[(size_t)row * D + head * 64 + F.lane] = (f16)(o * (float)SZ[(size_t)row * D + head * 64 + F.lane]);
        __syncthreads();
    }
}

constexpr int N_PHASES = 20;
__global__ void __launch_bounds__(NTHREADS, 2) mk_fwd(Args args) {
    extern __shared__ __attribute__((aligned(16))) unsigned char lds_raw[];
    Frame F;
    F.lds = (LAS unsigned char*)lds_raw;
    F.tid = threadIdx.x; F.lane = F.tid & 63; F.wave = __builtin_amdgcn_readfirstlane(F.tid >> 6); F.bid = blockIdx.x; F.nb = gridDim.x;
    F.ap = &args; F.out = args.out; F.ws = args.ws;
    volatile LAS unsigned* MISC = (volatile LAS unsigned*)(F.lds + LDS_BYTES - 256);
    if (F.tid < 64) MISC[F.tid] = 0u;
    __syncthreads();
    XcdBarrier bar; bar.bar = (unsigned*)(F.ws + WS_CTL) + 4096; bar.x = 0; bar.st = nullptr;
    const bool multi = (args.ph_hi - args.ph_lo) > 1;
    if (multi) bar = xcd_barrier_post((unsigned*)(F.ws + WS_CTL) + 4096, MISC + 8);
    f16* XA = WSP(f16, WS_XA);
    const int lo = args.ph_lo, hi = args.ph_hi;
#define PH(k, ...) do { if (lo <= (k) && (k) < hi) { if ((k) != lo) xcd_barrier(bar); __VA_ARGS__; } } while (0)
    PH(0, phase_prep(F));
    PH(1, { EpiStoreF16 E{WSP(f16, WS_U16), 4096, 4096}; gemm_naive(F, XA, D, WSP(f16, WS_WA_IN0), D, MT, 4096, D, 0, E); });
    PH(2, phase_convgate(F, 0));
    PH(3, { EpiResid E{XA, WSP(float, WS_V32)}; gemm_naive(F, WSP(f16, WS_A2), D, WSP(f16, WS_WA_OUT0), D, MT, D, D, 0, E); });
    PH(4, phase_ln(F, 0, false));
    PH(5, { EpiNsaProj E{WSP(f16, WS_Q16), WSP(float, WS_KV32), WSP(float, WS_GATES), WSP(f16, WS_SZ16), F.out}; gemm_naive(F, XA, D, WSP(f16, WS_WB_IN), D, MT, NBIN_PAD, D, 0, E); });
    PH(6, phase_compress_prompt(F));
    PH(7, phase_attn(F));
    PH(8, { EpiResid E{XA, WSP(float, WS_V32)}; gemm_naive(F, WSP(f16, WS_OG), D, WSP(f16, WS_WB_OUT), D, MT, D, D, 0, E); });
    PH(9, phase_ln(F, 1, false));
    PH(10, { EpiLruIn E{WSP(f16, WS_U16C), WSP(f16, WS_SZ16), F.out}; gemm_naive(F, XA, D, WSP(f16, WS_WC_IN), D, MT, 2048, D, 0, E); });
    PH(11, phase_conv4(F));
    PH(12, { EpiStoreF32 E{WSP(float, WS_RI32), 2048}; gemm_naive(F, WSP(f16, WS_UC16), D, WSP(f16, WS_WC_G), 256, MT, 2048, 256, 1, E); });
    PH(13, phase_scan(F));
    PH(14, { EpiResid E{XA, WSP(float, WS_V32)}; gemm_naive(F, WSP(f16, WS_YH), D, WSP(f16, WS_WC_OUT), D, MT, D, D, 0, E); });
    PH(15, phase_ln(F, 2, false));
    PH(16, { EpiStoreF16 E{WSP(f16, WS_U16), 4096, 4096}; gemm_naive(F, XA, D, WSP(f16, WS_WA_IN1), D, MT, 4096, D, 0, E); });
    PH(17, phase_convgate(F, 1));
    PH(18, { EpiResid E{XA, WSP(float, WS_V32)}; gemm_naive(F, WSP(f16, WS_A2), D, WSP(f16, WS_WA_OUT1), D, MT, D, D, 0, E); });
    PH(19, phase_ln(F, 3, true));
#undef PH
}

extern "C" void kernel_launch(void* const* d_in, const int* in_sizes, int n_in, void* d_out, int out_size, void* d_ws, size_t ws_size, hipStream_t stream) {
    static int grid = 0;
    if (grid == 0) {
        if (n_in != 25 || out_size != (int)O_END || ws_size < WS_END) { fprintf(stderr, "kernel_launch: unexpected shapes n_in %d out %d ws %zu\n", n_in, out_size, ws_size); grid = -1; return; }
        int dev = 0, cus = 0;
        if (hipGetDevice(&dev) != hipSuccess || hipDeviceGetAttribute(&cus, hipDeviceAttributeMultiprocessorCount, dev) != hipSuccess) { grid = -1; return; }
        if (hipFuncSetAttribute((const void*)mk_fwd, hipFuncAttributeMaxDynamicSharedMemorySize, LDS_BYTES) != hipSuccess) { fprintf(stderr, "kernel_launch: hipFuncSetAttribute failed\n"); grid = -1; return; }
        int per_cu = 0;
        (void)hipOccupancyMaxActiveBlocksPerMultiprocessor(&per_cu, (const void*)mk_fwd, NTHREADS, LDS_BYTES);
        (void)hipGetLastError();
        grid = cus;
    }
    if (grid < 0) return;
    (void)hipMemsetAsync((char*)d_ws + WS_CTL, 0, CTL_BYTES, stream);
    Args a{};
    for (int i = 0; i < 25; ++i) a.in[i] = d_in[i];
    a.out = (float*)d_out; a.ws = (unsigned char*)d_ws;
#if MK_ONE_LAUNCH
    a.ph_lo = 0; a.ph_hi = N_PHASES;
    void* kargs[] = {&a};
    hipError_t e = hipLaunchCooperativeKernel((const void*)mk_fwd, dim3(grid), dim3(NTHREADS), kargs, LDS_BYTES, stream);
    if (e != hipSuccess) fprintf(stderr, "cooperative launch failed: %s\n", hipGetErrorString(e));
#else
    for (int ph = 0; ph < N_PHASES; ++ph) { a.ph_lo = ph; a.ph_hi = ph + 1; hipLaunchKernelGGL(mk_fwd, dim3(grid), dim3(NTHREADS), LDS_BYTES, stream, a); }
#endif
}
```

```cpp
#include <hip/hip_runtime.h>
#include <cstdio>
#include <cstdint>

#ifndef MK_ONE_LAUNCH
#define MK_ONE_LAUNCH 1
#endif

typedef _Float16 f16;
typedef _Float16 f16x8 __attribute__((ext_vector_type(8)));
typedef _Float16 f16x4 __attribute__((ext_vector_type(4)));
typedef float f32x4 __attribute__((ext_vector_type(4)));
typedef unsigned u32x4 __attribute__((ext_vector_type(4)));
#define LAS __attribute__((address_space(3)))

constexpr int D = 1024, BATCH = 8, SEQ = 2048, DEC_B = 32, DEC_T = 4, PAST = 8192, PAGE = 128, NPAGES = PAST / PAGE;
constexpr int MP = BATCH * SEQ, MS = DEC_B * DEC_T, MT = MP + MS;
constexpr int NBIN = 2864, NBIN_PAD = 3072;
constexpr float ALPHA = 1.681792830507429f, LN_EPS = 1e-5f, LOG2E = 1.4426950408889634f;
constexpr int NWAVES = 8, NTHREADS = 512;
constexpr int LDS_BYTES = 147456;

constexpr size_t O_YP = 0, O_YS = 16777216, O_CAP = 16908288, O_CAS = 16941056, O_RP = 17072128, O_RS = 25460736,
                 O_WP = 25526272, O_WS = 26574848, O_HP = 30769152, O_HS = 30777344, O_CP = 30810112, O_CS = 30834688, O_END = 30932992;

constexpr size_t MiB = 1u << 20;
constexpr size_t WS_CTL = 0, CTL_BYTES = 1 * MiB;
constexpr size_t WS_WA_IN0 = 2 * MiB, WS_WA_IN1 = 10 * MiB, WS_WA_OUT0 = 18 * MiB, WS_WA_OUT1 = 20 * MiB, WS_WB_IN = 22 * MiB, WS_WB_OUT = 28 * MiB,
                 WS_WC_IN = 30 * MiB, WS_WC_G = 34 * MiB, WS_WC_OUT = 35 * MiB;
constexpr size_t WS_XA = 40 * MiB, WS_V32 = 74 * MiB, WS_U16 = 142 * MiB, WS_A2 = 278 * MiB, WS_Q16 = 312 * MiB, WS_SZ16 = 346 * MiB, WS_OG = 380 * MiB,
                 WS_KV32 = 414 * MiB, WS_GATES = 466 * MiB, WS_KVCP = 470 * MiB, WS_KVCS = 471 * MiB, WS_U16C = 479 * MiB, WS_UC16 = 513 * MiB,
                 WS_UC32 = 547 * MiB, WS_RI32 = 615 * MiB, WS_YH = 751 * MiB, WS_KV16 = 785 * MiB, WS_KVC16 = 811 * MiB, WS_END = 812 * MiB;

struct Args { const void* in[25]; float* out; unsigned char* ws; int ph_lo, ph_hi; };

__device__ __forceinline__ float sigmoidf_(float x) { return 1.f / (1.f + __expf(-x)); }
__device__ __forceinline__ float siluf_(float x) { return x / (1.f + __expf(-x)); }
__device__ __forceinline__ float wave_sum(float v) {
#pragma unroll
    for (int o = 1; o < 64; o <<= 1) v += __shfl_xor(v, o);
    return v;
}
__device__ __forceinline__ float wave_max(float v) {
#pragma unroll
    for (int o = 1; o < 64; o <<= 1) v = fmaxf(v, __shfl_xor(v, o));
    return v;
}

#define XB_TMO      128
#define XB_XCNT(j)  (256  + 64 * (j))
#define XB_XSUB(j)  (1280 + 64 * (j))
#define XB_XGEN(j)  (2304 + 64 * (j))
#define XB_TOP      3328
#define XB_TOPGEN   3392
#define XCD_BAR_WORDS 3456
#define XB_SPIN_CAP (1u << 22)
__device__ __forceinline__ unsigned xb_ld(unsigned* p)              { return __hip_atomic_load(p, __ATOMIC_RELAXED, __HIP_MEMORY_SCOPE_AGENT); }
__device__ __forceinline__ unsigned xb_add(unsigned* p, unsigned v) { return __hip_atomic_fetch_add(p, v, __ATOMIC_RELAXED, __HIP_MEMORY_SCOPE_AGENT); }
__device__ __forceinline__ unsigned xb_xcc_id() { return (unsigned)__builtin_amdgcn_s_getreg((3 << 11) | 20) & 0xFu; }
#define XB_SPIN(cond, bar) do { unsigned _sp = 0; while (cond) { __builtin_amdgcn_s_sleep(1); \
    if ((++_sp & 255u) == 0u) { if (xb_ld(&(bar)[XB_TMO])) break; if (_sp > XB_SPIN_CAP) { atomicAdd(&(bar)[XB_TMO], 1u); break; } } } } while (0)
struct XcdBarrier { unsigned* bar; unsigned x; volatile LAS unsigned* st; };
__device__ __forceinline__ XcdBarrier xcd_barrier_post(unsigned* bar, volatile LAS unsigned* st) {
    XcdBarrier b; b.bar = bar; b.x = xb_xcc_id(); b.st = st;
    if (threadIdx.x == 0) (void)xb_add(&bar[XB_XCNT(b.x)], 1u);
    return b;
}
__device__ __forceinline__ void xcd_barrier_complete(unsigned* bar, unsigned x, unsigned& nloc, unsigned& nx) {
    const unsigned G = gridDim.x * gridDim.y * gridDim.z;
    unsigned sum, cnt, mine, sp = 0u;
    for (;;) {
        sum = 0u; cnt = 0u; mine = 0u;
#pragma unroll
        for (unsigned j = 0; j < 16; ++j) { const unsigned c = xb_ld(&bar[XB_XCNT(j)]); sum += c; cnt += (c > 0u) ? 1u : 0u; mine = (j == x) ? c : mine; }
        if (sum == G) break;
        __builtin_amdgcn_s_sleep(1);
        if ((++sp & 255u) == 0u) { if (xb_ld(&bar[XB_TMO])) break; if (sp > XB_SPIN_CAP) { atomicAdd(&bar[XB_TMO], 1u); break; } }
    }
    nloc = mine > 0u ? mine : 1u; nx = cnt > 0u ? cnt : 1u;
}
__device__ __forceinline__ void xcd_barrier(const XcdBarrier& b) {
    asm volatile("s_waitcnt vmcnt(0)" ::: "memory");
    __syncthreads();
    if (threadIdx.x == 0) {
        unsigned* bar = b.bar;
        __builtin_amdgcn_s_waitcnt(0);
        unsigned nloc = b.st[0], nx = b.st[1];
        if (nloc == 0u) { xcd_barrier_complete(bar, b.x, nloc, nx); b.st[0] = nloc; b.st[1] = nx; }
        const unsigned old = xb_add(&bar[XB_XSUB(b.x)], 1u);
        const unsigned gen = old / nloc;
        if (old + 1u == (gen + 1u) * nloc) {
            __builtin_amdgcn_fence(__ATOMIC_RELEASE, "agent");
            asm volatile("s_waitcnt vmcnt(0)" ::: "memory");
            const unsigned og = xb_add(&bar[XB_TOP], 1u);
            const unsigned tg = og / nx;
            if (og + 1u == (tg + 1u) * nx) xb_add(&bar[XB_TOPGEN], 1u);
            else XB_SPIN(xb_ld(&bar[XB_TOPGEN]) == tg, bar);
            __builtin_amdgcn_fence(__ATOMIC_ACQUIRE, "agent");
            xb_add(&bar[XB_XGEN(b.x)], 1u);
            asm volatile("s_waitcnt vmcnt(0)" ::: "memory");
        } else {
            XB_SPIN(xb_ld(&bar[XB_XGEN(b.x)]) == gen, bar);
            __builtin_amdgcn_fence(__ATOMIC_ACQUIRE, "agent");
            asm volatile("s_waitcnt vmcnt(0)" ::: "memory");
        }
    }
    __syncthreads();
}

namespace pg8 {
#define PG8_LAS __attribute__((address_space(3)))
typedef unsigned short bf16_t;
typedef _Float16 h16x8 __attribute__((ext_vector_type(8)));
typedef float f32x4 __attribute__((ext_vector_type(4)));
typedef unsigned u32x4 __attribute__((ext_vector_type(4)));
constexpr int BM = 256, BK = 64, HALF = 128, HTB = HALF * BK * 2  , STAGE_BYTES = 8 * HTB, NXCD = 8, WGM = 8;

__host__ __device__ __forceinline__ int lds_byte(int r, int c) { const int st = (r >> 4) * 2 + (c >> 5), rr = r & 15, cc = c & 31, ob = rr * 64 + cc * 2; return st * 1024 + (ob ^ (((ob >> 9) & 1) << 5)); }
__host__ __device__ __forceinline__ void stage_rc(int b, int& R, int& C) { const int st = b / 1024, sb = b % 1024, swz = sb ^ (((sb >> 9) & 1) << 5); R = (st >> 1) * 16 + swz / 64; C = (st & 1) * 32 + (swz % 64) / 2; }
__host__ __device__ __forceinline__ int perm32(int rho) { const int n = rho >> 4, i = rho & 15; return 8 * (i >> 2) + 4 * n + (i & 3); }

struct Unit { int pm, pn; };
struct Gemm { const bf16_t* A; const bf16_t* Bt; int M, N, K; };

struct StaticOrder {
    int nM, nN, nwg, G, c;
    __host__ __device__ void init(int M, int N, int G_, int c_) { nM = M / BM; nN = N / BM; nwg = nM * nN; G = G_; c = c_; }
    __host__ __device__ bool next(int i, Unit& u) const {
        const long L = (long)i * G + c; if (L >= nwg) return false;
        int wgid = (int)L; { const int q = nwg / NXCD, r = nwg % NXCD, xcd = wgid % NXCD, off = wgid / NXCD; wgid = (xcd < r ? xcd * (q + 1) : r * (q + 1) + (xcd - r) * q) + off; }
        const int nig = WGM * nN, gid = wgid / nig, fm = gid * WGM, gsz = (nM - fm) < WGM ? (nM - fm) : WGM;
        u.pm = fm + ((wgid % nig) % gsz); u.pn = (wgid % nig) / gsz; return true;
    }
    __device__ __forceinline__ void a_ready(const Unit&) const {}
    __device__ __forceinline__ void done(const Unit&) const {}
};

template <class Epi, class Sched, bool ALIGN_EPI = false, bool SP2 = false>
__device__ __forceinline__ void gemm_phase(PG8_LAS unsigned char* lds, const Gemm g, const Sched& S, const Epi& E) {
    const int tid = threadIdx.x, wid = __builtin_amdgcn_readfirstlane(tid >> 6), lane = tid & 63, wr = wid >> 2, wc = wid & 3, fr = lane & 15, fq = lane >> 4;
    const int K = g.K, nt = K / BK;
    unsigned voffA[2], voffB[2];
#pragma unroll
    for (int i = 0; i < 2; ++i) { int R, C; stage_rc(tid * 16 + i * 8192, R, C); const int Rb = Epi::PERM ? ((R & ~31) + perm32(R & 31)) : R;
        voffA[i] = (unsigned)(R * K + C) * 2u; voffB[i] = (unsigned)(Rb * K + C) * 2u; }
    const size_t kstep = (size_t)(BK * 2);
    const size_t hstep = (size_t)HALF * K * 2;
    const size_t tstep = 2 * hstep;
    const unsigned ldsw = (unsigned)wid * 1024u;
    const int aoff = lds_byte(wr * 64 + fr, fq * 8), boff = lds_byte(wc * 32 + fr, fq * 8);
#define PG8_SA(b, h) (((b) * 2 + (h)) * HTB)
#define PG8_SB(b, h) ((4 + (b) * 2 + (h)) * HTB)
#define PG8_STAGE(bufoff, gbase, voff) do { _Pragma("unroll") for (int _i = 0; _i < 2; ++_i) \
        __builtin_amdgcn_global_load_lds((const unsigned*)((const char*)(gbase) + (voff)[_i]), (PG8_LAS unsigned*)(lds + (bufoff) + ldsw + _i * 8192), 16, 0, 0); } while (0)
#define PG8_LDA(dst, b, h) do { _Pragma("unroll") for (int m = 0; m < 4; ++m) _Pragma("unroll") for (int k = 0; k < 2; ++k) dst[m][k] = *(const PG8_LAS h16x8*)(lds + PG8_SA(b, h) + aoff + m * 2048 + k * 1024); } while (0)
#define PG8_LDB(dst, b, h) do { _Pragma("unroll") for (int n = 0; n < 2; ++n) _Pragma("unroll") for (int k = 0; k < 2; ++k) dst[n][k] = *(const PG8_LAS h16x8*)(lds + PG8_SB(b, h) + boff + n * 2048 + k * 1024); } while (0)
#define PG8_MMA(ai, bj, At, Bt) do { __builtin_amdgcn_s_setprio(1); _Pragma("unroll") for (int m = 0; m < 4; ++m) _Pragma("unroll") for (int n = 0; n < 2; ++n) _Pragma("unroll") for (int k = 0; k < 2; ++k) \
        acc[ai][bj][m][n] = __builtin_amdgcn_mfma_f32_16x16x32_f16(Bt[n][k], At[m][k], acc[ai][bj][m][n], 0, 0, 0); __builtin_amdgcn_s_setprio(0); } while (0)
#define PG8_WAIT_V(n) asm volatile("s_waitcnt vmcnt(" #n ")" ::: "memory")
#define PG8_WAIT_L(n) asm volatile("s_waitcnt lgkmcnt(" #n ")" ::: "memory")
#define PG8_BAR __builtin_amdgcn_s_barrier()
#define PG8_SCHED __builtin_amdgcn_sched_barrier(0)
    Unit cur, nxt; int ui = 0;
    if (!S.next(0, cur)) return;
    f32x4 acc[2][2][4][2];
#pragma unroll
    for (int a = 0; a < 2; ++a)
#pragma unroll
        for (int b = 0; b < 2; ++b)
#pragma unroll
            for (int m = 0; m < 4; ++m)
#pragma unroll
                for (int n = 0; n < 2; ++n) acc[a][b][m][n] = (f32x4){0.f, 0.f, 0.f, 0.f};
    h16x8 At[4][2], B0[2][2], B1[2][2];
    const char* cA = (const char*)g.A + (size_t)cur.pm * tstep; const char* cB = (const char*)g.Bt + (size_t)cur.pn * tstep;
    S.a_ready(cur);
    if constexpr (SP2) {
        PG8_STAGE(PG8_SB(0, 0), cB, voffB); PG8_STAGE(PG8_SB(0, 1), cB + hstep, voffB); PG8_STAGE(PG8_SA(0, 0), cA, voffA); PG8_STAGE(PG8_SA(0, 1), cA + hstep, voffA);
        if (wr == 1) PG8_BAR;
        PG8_WAIT_V(2); PG8_BAR;
        PG8_STAGE(PG8_SB(1, 0), cB + kstep, voffB); PG8_STAGE(PG8_SA(1, 0), cA + kstep, voffA); PG8_STAGE(PG8_SB(1, 1), cB + hstep + kstep, voffB);
        PG8_WAIT_V(6); PG8_BAR;
    } else {
        PG8_STAGE(PG8_SB(0, 0), cB, voffB); PG8_STAGE(PG8_SA(0, 0), cA, voffA); PG8_STAGE(PG8_SB(0, 1), cB + hstep, voffB); PG8_STAGE(PG8_SA(0, 1), cA + hstep, voffA);
        if (wr == 1) PG8_BAR;
        PG8_WAIT_V(4); PG8_BAR;
        PG8_STAGE(PG8_SB(1, 0), cB + kstep, voffB); PG8_STAGE(PG8_SA(1, 0), cA + kstep, voffA); PG8_STAGE(PG8_SB(1, 1), cB + hstep + kstep, voffB);
        PG8_WAIT_V(6); PG8_BAR;
    }
    for (;;) {
        const bool has_next = S.next(ui + 1, nxt);
        const char* nA = has_next ? (const char*)g.A + (size_t)nxt.pm * tstep : cA; const char* nB = has_next ? (const char*)g.Bt + (size_t)nxt.pn * tstep : cB;
        for (int t = 0; t < nt; t += 2) {
            const bool last = (t == nt - 2);
            const char* a1 = cA + (size_t)(t + 1) * kstep;
            const char* a2 = last ? nA : cA + (size_t)(t + 2) * kstep; const char* b2 = last ? nB : cB + (size_t)(t + 2) * kstep;
            const char* a3 = a2 + kstep; const char* b3 = b2 + kstep;
            if (last && has_next) S.a_ready(nxt);
            if constexpr (SP2) {
            PG8_LDB(B0, 0, 0); PG8_LDB(B1, 0, 1); PG8_SCHED; PG8_LDA(At, 0, 0); PG8_STAGE(PG8_SA(1, 1), a1 + hstep, voffA);
            PG8_WAIT_V(8); PG8_WAIT_L(0); PG8_BAR; PG8_MMA(0, 0, At, B0); PG8_MMA(0, 1, At, B1); PG8_BAR; PG8_SCHED;
            PG8_LDA(At, 0, 1); PG8_STAGE(PG8_SB(0, 0), b2, voffB); PG8_STAGE(PG8_SB(0, 1), b2 + hstep, voffB); PG8_STAGE(PG8_SA(0, 0), a2, voffA);
            PG8_WAIT_V(8); PG8_WAIT_L(0); PG8_BAR; PG8_MMA(1, 0, At, B0); PG8_MMA(1, 1, At, B1); PG8_BAR; PG8_SCHED;
            PG8_LDB(B0, 1, 0); PG8_LDB(B1, 1, 1); PG8_SCHED; PG8_LDA(At, 1, 0); PG8_STAGE(PG8_SA(0, 1), a2 + hstep, voffA);
            PG8_WAIT_V(8); PG8_WAIT_L(0); PG8_BAR; PG8_MMA(0, 0, At, B0); PG8_MMA(0, 1, At, B1); PG8_BAR; PG8_SCHED;
            PG8_LDA(At, 1, 1); PG8_STAGE(PG8_SB(1, 0), b3, voffB); PG8_STAGE(PG8_SB(1, 1), b3 + hstep, voffB); PG8_STAGE(PG8_SA(1, 0), a3, voffA);
            PG8_WAIT_V(8); PG8_WAIT_L(0); PG8_BAR; PG8_MMA(1, 0, At, B0); PG8_MMA(1, 1, At, B1); PG8_BAR; PG8_SCHED;
            } else {
            PG8_LDB(B0, 0, 0); PG8_SCHED; PG8_LDA(At, 0, 0); PG8_STAGE(PG8_SA(1, 1), a1 + hstep, voffA);
            PG8_WAIT_L(8); PG8_BAR; PG8_WAIT_L(0); PG8_MMA(0, 0, At, B0); PG8_BAR; PG8_SCHED;
            PG8_LDB(B1, 0, 1); PG8_STAGE(PG8_SB(0, 0), b2, voffB);
            PG8_BAR; PG8_WAIT_L(0); PG8_MMA(0, 1, At, B1); PG8_BAR;
            PG8_LDA(At, 0, 1); PG8_STAGE(PG8_SA(0, 0), a2, voffA);
            PG8_BAR; PG8_WAIT_L(0); PG8_MMA(1, 0, At, B0); PG8_BAR; PG8_SCHED;
            PG8_STAGE(PG8_SB(0, 1), b2 + hstep, voffB);
            PG8_WAIT_V(6); PG8_BAR; PG8_MMA(1, 1, At, B1); PG8_BAR;
            PG8_LDB(B0, 1, 0); PG8_SCHED; PG8_LDA(At, 1, 0); PG8_STAGE(PG8_SA(0, 1), a2 + hstep, voffA);
            PG8_WAIT_L(8); PG8_BAR; PG8_WAIT_L(0); PG8_MMA(0, 0, At, B0); PG8_BAR; PG8_SCHED;
            PG8_LDB(B1, 1, 1); PG8_STAGE(PG8_SB(1, 0), b3, voffB);
            PG8_BAR; PG8_WAIT_L(0); PG8_MMA(0, 1, At, B1); PG8_BAR;
            PG8_LDA(At, 1, 1); PG8_STAGE(PG8_SA(1, 0), a3, voffA);
            PG8_BAR; PG8_WAIT_L(0); PG8_MMA(1, 0, At, B0); PG8_BAR; PG8_SCHED;
            PG8_STAGE(PG8_SB(1, 1), b3 + hstep, voffB);
            PG8_WAIT_V(6); PG8_BAR; PG8_MMA(1, 1, At, B1); PG8_BAR;
            }
        }
        if constexpr (ALIGN_EPI) { if (wr == 0) PG8_BAR; }
        if constexpr (!Epi::AFTER_DRAIN) { E(acc, cur, wr, wc, fr, fq); S.done(cur); }
        if (!has_next) break;
#pragma unroll
        for (int a = 0; a < 2; ++a)
#pragma unroll
            for (int b = 0; b < 2; ++b)
#pragma unroll
                for (int m = 0; m < 4; ++m)
#pragma unroll
                    for (int n = 0; n < 2; ++n) acc[a][b][m][n] = (f32x4){0.f, 0.f, 0.f, 0.f};
        cur = nxt; cA = nA; cB = nB; ++ui;
        if constexpr (ALIGN_EPI) { if (wr == 1) PG8_BAR; }
    }
    PG8_WAIT_V(0);
    if constexpr (!ALIGN_EPI) { if (wr == 0) PG8_BAR; }
    PG8_BAR;
    if constexpr (Epi::AFTER_DRAIN) { E.fused(acc, cur, wr, wc, fr, fq, lds, wid, lane); S.done(cur); }
#undef PG8_SA
#undef PG8_SB
#undef PG8_STAGE
#undef PG8_LDA
#undef PG8_LDB
#undef PG8_MMA
#undef PG8_WAIT_V
#undef PG8_WAIT_L
#undef PG8_BAR
#undef PG8_SCHED
}

template <class Fn> struct EpiAdapt {
    static constexpr bool PERM = false, AFTER_DRAIN = false; Fn fn;
    __device__ __forceinline__ void operator()(const f32x4 (&acc)[2][2][4][2], const Unit& u, int wr, int wc, int fr, int fq) const {
#pragma unroll
        for (int ai = 0; ai < 2; ++ai)
#pragma unroll
            for (int m = 0; m < 4; ++m)
#pragma unroll
                for (int bj = 0; bj < 2; ++bj)
#pragma unroll
                    for (int n = 0; n < 2; ++n) fn(u.pm * BM + ai * HALF + wr * 64 + m * 16 + fr, u.pn * BM + bj * HALF + wc * 32 + n * 16 + 4 * fq, acc[ai][bj][m][n]);
    }
};
}

struct Frame {
    LAS unsigned char* lds;
    int tid, lane, wave, bid, nb;
    const Args* ap;
    float* out; unsigned char* ws;
};
#define INF(k) ((const float*)F.ap->in[k])
#define WSP(T, off) ((T*)(F.ws + (off)))

__device__ __forceinline__ void transpose_item(const float* W, int K, int N, f16* WT, int row_off, LAS float* scr, int item, int lane, int nblk) {
    const int kb = item / nblk, nb = item % nblk, k0 = 64 * kb, n0 = 32 * nb;
#pragma unroll 8
    for (int i = 0; i < 32; ++i) { const int kk = 2 * i + (lane >> 5); const int n = n0 + (lane & 31); scr[kk * 33 + (lane & 31)] = (n < N) ? W[(size_t)(k0 + kk) * N + n] : 0.f; }
    asm volatile("s_waitcnt lgkmcnt(0)" ::: "memory");
    const int c = lane & 7;
#pragma unroll
    for (int j = 0; j < 4; ++j) { const int n = (lane >> 3) + 8 * j; const LAS float* s = scr + (8 * c) * 33 + n;
        f16x8 o; o[0] = (f16)s[0 * 33]; o[1] = (f16)s[1 * 33]; o[2] = (f16)s[2 * 33]; o[3] = (f16)s[3 * 33]; o[4] = (f16)s[4 * 33]; o[5] = (f16)s[5 * 33]; o[6] = (f16)s[6 * 33]; o[7] = (f16)s[7 * 33];
        *(f16x8*)(WT + (size_t)(row_off + n0 + n) * K + k0 + 8 * c) = o; }
    asm volatile("s_waitcnt lgkmcnt(0)" ::: "memory");
}
__device__ __forceinline__ void phase_prep(Frame& F) {
    LAS float* scr = (LAS float*)(F.lds + F.wave * 16384);
    const int gw = F.bid * NWAVES + F.wave, NGW = F.nb * NWAVES;
    constexpr int I_AIN = 16 * 128, I_SQ = 16 * 32, I_BIN = 16 * 96, I_CIN = 16 * 64, I_G = 4 * 8;
    constexpr int NITEMS = 2 * I_AIN + 2 * I_SQ + I_BIN + I_SQ + I_CIN + 8 * I_G + I_SQ;
    for (int it = gw; it < NITEMS; it += NGW) {
        int r = it;
        if (r < I_AIN) { transpose_item(INF(10), D, 4096, WSP(f16, WS_WA_IN0), 0, scr, r, F.lane, 128); continue; } r -= I_AIN;
        if (r < I_AIN) { transpose_item(INF(10) + (size_t)D * 4096, D, 4096, WSP(f16, WS_WA_IN1), 0, scr, r, F.lane, 128); continue; } r -= I_AIN;
        if (r < I_SQ) { transpose_item(INF(12), D, D, WSP(f16, WS_WA_OUT0), 0, scr, r, F.lane, 32); continue; } r -= I_SQ;
        if (r < I_SQ) { transpose_item(INF(12) + (size_t)D * D, D, D, WSP(f16, WS_WA_OUT1), 0, scr, r, F.lane, 32); continue; } r -= I_SQ;
        if (r < I_BIN) { transpose_item(INF(13), D, NBIN, WSP(f16, WS_WB_IN), 0, scr, r, F.lane, 96); continue; } r -= I_BIN;
        if (r < I_SQ) { transpose_item(INF(15), D, D, WSP(f16, WS_WB_OUT), 0, scr, r, F.lane, 32); continue; } r -= I_SQ;
        if (r < I_CIN) { transpose_item(INF(16), D, 2048, WSP(f16, WS_WC_IN), 0, scr, r, F.lane, 64); continue; } r -= I_CIN;
        if (r < 8 * I_G) { const int blk = r / I_G, ri = r % I_G;
            const float* src = (blk < 4 ? INF(19) : INF(21)) + (size_t)(blk & 3) * 256 * 256;
            transpose_item(src, 256, 256, WSP(f16, WS_WC_G), blk * 256, scr, ri, F.lane, 8); continue; } r -= 8 * I_G;
        transpose_item(INF(24), D, D, WSP(f16, WS_WC_OUT), 0, scr, r, F.lane, 32);
    }
    const int gt = F.bid * NTHREADS + F.tid, NGT = F.nb * NTHREADS;
    f16* XA = WSP(f16, WS_XA);
    for (int i = gt; i < MT * 128; i += NGT) {
        const int row = i >> 7, c8 = (i & 127) * 8;
        const float* src = (row < MP) ? INF(0) + (size_t)row * D + c8 : INF(1) + (size_t)(row - MP) * D + c8;
        const f32x4 a = *(const f32x4*)src, b = *(const f32x4*)(src + 4);
        f16x8 o; o[0] = (f16)a[0]; o[1] = (f16)a[1]; o[2] = (f16)a[2]; o[3] = (f16)a[3]; o[4] = (f16)b[0]; o[5] = (f16)b[1]; o[6] = (f16)b[2]; o[7] = (f16)b[3];
        *(f16x8*)(XA + (size_t)row * D + c8) = o;
    }
    float* KVCS = WSP(float, WS_KVCS);
    for (int it = gw; it < DEC_B * 256; it += NGW) {
        const int b = it >> 8, n = it & 255;
        const int page = ((const int*)F.ap->in[7])[b * NPAGES + (n >> 2)];
        const float* src = INF(2) + ((size_t)page * PAGE + (n & 3) * 32) * 512 + F.lane * 4;
        const int f = F.lane * 4;
        const float* w = INF(14) + (f >> 7) * 4096 + (f & 127);
        f32x4 acc = {0.f, 0.f, 0.f, 0.f};
#pragma unroll 8
        for (int j = 0; j < 32; ++j) { const f32x4 v = *(const f32x4*)(src + (size_t)j * 512); const f32x4 ww = *(const f32x4*)(w + j * 128); acc += v * ww; }
        *(f32x4*)(KVCS + (size_t)it * 256 + f) = acc;
    }
    for (int i = gt; i < DEC_B * 508 * 64; i += NGT) {
        const int b = i / (508 * 64), r = i % (508 * 64);
        *(f32x4*)(F.out + O_WS + (size_t)b * 512 * 256 + (size_t)r * 4) = *(const f32x4*)(INF(3) + (size_t)b * 512 * 256 + 4 * 256 + (size_t)r * 4);
    }
}

template <int MTL, int NTL>
__device__ __forceinline__ void wave_gemm(const f16* A, int lda, const f16* Bt, int ldb, int K, int row0, int col0, int lane, f32x4 (&acc)[MTL][NTL]) {
    const int fr = lane & 15, fq = lane >> 4;
    const f16* ap = A + (size_t)(row0 + fr) * lda + 8 * fq;
    const f16* bp = Bt + (size_t)(col0 + fr) * ldb + 8 * fq;
    for (int k = 0; k < K; k += 32) {
        f16x8 a[MTL], b[NTL];
#pragma unroll
        for (int m = 0; m < MTL; ++m) a[m] = *(const f16x8*)(ap + (size_t)m * 16 * lda + k);
#pragma unroll
        for (int n = 0; n < NTL; ++n) b[n] = *(const f16x8*)(bp + (size_t)n * 16 * ldb + k);
#pragma unroll
        for (int m = 0; m < MTL; ++m)
#pragma unroll
            for (int n = 0; n < NTL; ++n) acc[m][n] = __builtin_amdgcn_mfma_f32_16x16x32_f16(b[n], a[m], acc[m][n], 0, 0, 0);
    }
}
template <class Epi>
__device__ __forceinline__ void gemm_naive(Frame& F, const f16* A, int lda, const f16* Bt, int ldb, int mrow0, int M, int N, int K, int acolmode, const Epi& E) {
    const int nM = M / 128, nN = N / 256, nit = nM * nN;
    const int wr = F.wave >> 2, wc = F.wave & 3, fr = F.lane & 15, fq = F.lane >> 4;
    for (int it = F.bid; it < nit; it += F.nb) {
        const int tm = it / nN, tn = it % nN;
        const int row0 = mrow0 + tm * 128 + wr * 64, col0 = tn * 256 + wc * 64;
        f32x4 acc[4][4];
#pragma unroll
        for (int m = 0; m < 4; ++m)
#pragma unroll
            for (int n = 0; n < 4; ++n) acc[m][n] = (f32x4){0.f, 0.f, 0.f, 0.f};
        const int acol = acolmode ? ((col0 & 1023) >> 8) * 256 : 0;
        wave_gemm<4, 4>(A + acol, lda, Bt, ldb, K, row0, col0, F.lane, acc);
#pragma unroll
        for (int m = 0; m < 4; ++m)
#pragma unroll
            for (int n = 0; n < 4; ++n) E(row0 + 16 * m + fr, col0 + 16 * n + 4 * fq, acc[m][n]);
    }
}
template <class Fn>
__device__ __forceinline__ void run_gemm(Frame& F, const f16* A, const f16* Bt, int N, const Fn& fn) {
    pg8::Gemm g{(const pg8::bf16_t*)A, (const pg8::bf16_t*)Bt, MP, N, D};
    pg8::StaticOrder S; S.init(MP, N, F.nb, F.bid);
    pg8::EpiAdapt<Fn> E{fn};
    pg8::gemm_phase<pg8::EpiAdapt<Fn>, pg8::StaticOrder, true, true>(F.lds, g, S, E);
    gemm_naive(F, A, D, Bt, D, MP, MS, N, D, 0, fn);
}
struct EpiStoreF16 { f16* O; int ldo; int ncols;
    __device__ __forceinline__ void operator()(int row, int col, f32x4 v) const { if (col < ncols) { f16x4 o; o[0] = (f16)v[0]; o[1] = (f16)v[1]; o[2] = (f16)v[2]; o[3] = (f16)v[3]; *(f16x4*)(O + (size_t)row * ldo + col) = o; } } };
struct EpiStoreF32 { float* O; int ldo;
    __device__ __forceinline__ void operator()(int row, int col, f32x4 v) const { *(f32x4*)(O + (size_t)row * ldo + col) = v; } };
struct EpiResid { const f16* X; float* V;
    __device__ __forceinline__ void operator()(int row, int col, f32x4 v) const { const f16x4 x = *(const f16x4*)(X + (size_t)row * D + col);
        f32x4 o; o[0] = ALPHA * (float)x[0] + v[0]; o[1] = ALPHA * (float)x[1] + v[1]; o[2] = ALPHA * (float)x[2] + v[2]; o[3] = ALPHA * (float)x[3] + v[3]; *(f32x4*)(V + (size_t)row * D + col) = o; } };
struct EpiNsaProj { f16* Q; float* KV; float* G; f16* SZ; float* out; f16* KV16;
    __device__ __forceinline__ void operator()(int row, int col, f32x4 v) const {
        if (col < 1024) { const float qs_ = 0.125f * LOG2E; f16x4 o; o[0] = (f16)(v[0] * qs_); o[1] = (f16)(v[1] * qs_); o[2] = (f16)(v[2] * qs_); o[3] = (f16)(v[3] * qs_); *(f16x4*)(Q + (size_t)row * D + col) = o; }
        else if (col < 1792) { const int c = col - 1024; *(f32x4*)(KV + (size_t)row * 768 + c) = v; { f16x4 o; o[0] = (f16)v[0]; o[1] = (f16)v[1]; o[2] = (f16)v[2]; o[3] = (f16)v[3]; *(f16x4*)(KV16 + (size_t)row * 768 + c) = o; }
            if (c < 512) { if (row < MP) *(f32x4*)(out + O_RP + (size_t)row * 512 + c) = v; else *(f32x4*)(out + O_RS + (size_t)(row - MP) * 512 + c) = v; }
            else { const int cw = c - 512;
                if (row < MP) { const int b = row >> 11, t = row & 2047; if (t >= 1536) *(f32x4*)(out + O_WP + ((size_t)b * 512 + (t - 1536)) * 256 + cw) = v; }
                else { const int s = row - MP, b = s >> 2, t = s & 3; *(f32x4*)(out + O_WS + ((size_t)b * 512 + 508 + t) * 256 + cw) = v; } } }
        else if (col < 1840) { f32x4 o; o[0] = sigmoidf_(v[0]); o[1] = sigmoidf_(v[1]); o[2] = sigmoidf_(v[2]); o[3] = sigmoidf_(v[3]); *(f32x4*)(G + (size_t)row * 48 + (col - 1792)) = o; }
        else if (col < 2864) { f16x4 o; o[0] = (f16)siluf_(v[0]); o[1] = (f16)siluf_(v[1]); o[2] = (f16)siluf_(v[2]); o[3] = (f16)siluf_(v[3]); *(f16x4*)(SZ + (size_t)row * D + (col - 1840)) = o; }
    } };
struct EpiLruIn { f16* U; f16* SZ; float* out;
    __device__ __forceinline__ void operator()(int row, int col, f32x4 v) const {
        if (col < 1024) { f16x4 o; o[0] = (f16)v[0]; o[1] = (f16)v[1]; o[2] = (f16)v[2]; o[3] = (f16)v[3]; *(f16x4*)(U + (size_t)row * D + col) = o;
            if (row < MP) { const int b = row >> 11, t = row & 2047; if (t >= 2045) *(f32x4*)(out + O_CP + ((size_t)b * 3 + (t - 2045)) * D + col) = v; }
            else { const int s = row - MP, b = s >> 2, t = s & 3; if (t >= 1) *(f32x4*)(out + O_CS + ((size_t)b * 3 + (t - 1)) * D + col) = v; } }
        else { f16x4 o; o[0] = (f16)siluf_(v[0]); o[1] = (f16)siluf_(v[1]); o[2] = (f16)siluf_(v[2]); o[3] = (f16)siluf_(v[3]); *(f16x4*)(SZ + (size_t)row * D + (col - 1024)) = o; }
    } };

__device__ __forceinline__ void phase_convgate(Frame& F, int j) {
    const f16* U = WSP(f16, WS_U16); f16* A2 = WSP(f16, WS_A2);
    const float* cw = INF(11) + (size_t)j * 3 * D;
    const int gt = F.bid * NTHREADS + F.tid, NGT = F.nb * NTHREADS;
    for (int i = gt; i < MT * 128; i += NGT) {
        const int row = i >> 7, c8 = (i & 127) * 8;
        int t, b; bool samp = row >= MP;
        if (!samp) { b = row >> 11; t = row & 2047; } else { const int s = row - MP; b = s >> 2; t = s & 3; }
        float u[3][8];
#pragma unroll
        for (int k = 0; k < 3; ++k) {
            const int tt = t - 2 + k;
            if (tt >= 0) { const f16x8 h = *(const f16x8*)(U + (size_t)(row - 2 + k) * 4096 + c8), c = *(const f16x8*)(U + (size_t)(row - 2 + k) * 4096 + 2048 + c8);
#pragma unroll
                for (int e = 0; e < 8; ++e) u[k][e] = (float)c[e] * (float)h[e]; }
            else if (samp) { const float* st = INF(4) + (((size_t)j * DEC_B + b) * 2 + (2 + tt)) * D + c8;
#pragma unroll
                for (int e = 0; e < 8; ++e) u[k][e] = st[e]; }
            else {
#pragma unroll
                for (int e = 0; e < 8; ++e) u[k][e] = 0.f; }
        }
        const f16x8 bg = *(const f16x8*)(U + (size_t)row * 4096 + 1024 + c8), z = *(const f16x8*)(U + (size_t)row * 4096 + 3072 + c8);
        f16x8 o;
#pragma unroll
        for (int e = 0; e < 8; ++e) { const float conv = cw[c8 + e] * u[0][e] + cw[D + c8 + e] * u[1][e] + cw[2 * D + c8 + e] * u[2][e];
            o[e] = (f16)(siluf_((float)z[e]) * (float)bg[e] * conv); }
        *(f16x8*)(A2 + (size_t)row * D + c8) = o;
        if (!samp && t >= 2046) { float* dst = F.out + O_CAP + (((size_t)j * BATCH + b) * 2 + (t - 2046)) * D + c8;
#pragma unroll
            for (int e = 0; e < 8; ++e) dst[e] = u[2][e]; }
        if (samp && t >= 2) { float* dst = F.out + O_CAS + (((size_t)j * DEC_B + b) * 2 + (t - 2)) * D + c8;
#pragma unroll
            for (int e = 0; e < 8; ++e) dst[e] = u[2][e]; }
    }
}
__device__ __forceinline__ void phase_ln(Frame& F, int li, bool last) {
    const float* V = WSP(float, WS_V32); f16* XA = WSP(f16, WS_XA);
    const float* g = INF(8) + (size_t)li * D; const float* bb = INF(9) + (size_t)li * D;
    const int gw = F.bid * NWAVES + F.wave, NGW = F.nb * NWAVES;
    for (int row = gw; row < MT; row += NGW) {
        const f32x4* vr = (const f32x4*)(V + (size_t)row * D) + F.lane;
        f32x4 v[4]; float s = 0.f;
#pragma unroll
        for (int q = 0; q < 4; ++q) { v[q] = vr[64 * q]; s += (v[q][0] + v[q][1]) + (v[q][2] + v[q][3]); }
        const float mean = wave_sum(s) * (1.f / D); float s2 = 0.f;
#pragma unroll
        for (int q = 0; q < 4; ++q) { v[q] = v[q] - mean; s2 += (v[q][0] * v[q][0] + v[q][1] * v[q][1]) + (v[q][2] * v[q][2] + v[q][3] * v[q][3]); }
        const float rstd = 1.f / sqrtf(wave_sum(s2) * (1.f / D) + LN_EPS);
#pragma unroll
        for (int q = 0; q < 4; ++q) { const int col = 4 * F.lane + 256 * q; const f32x4 gg = *(const f32x4*)(g + col), be = *(const f32x4*)(bb + col);
            const f32x4 y = v[q] * rstd * gg + be;
            f16x4 o; o[0] = (f16)y[0]; o[1] = (f16)y[1]; o[2] = (f16)y[2]; o[3] = (f16)y[3]; *(f16x4*)(XA + (size_t)row * D + col) = o;
            if (last) { float* dst = (row < MP) ? F.out + O_YP + (size_t)row * D + col : F.out + O_YS + (size_t)(row - MP) * D + col; *(f32x4*)dst = y; } }
    }
}
__device__ __forceinline__ void phase_compress_prompt(Frame& F) {
    const float* KV = WSP(float, WS_KV32); float* KVCP = WSP(float, WS_KVCP);
    const int gw = F.bid * NWAVES + F.wave, NGW = F.nb * NWAVES;
    for (int it = gw; it < BATCH * 64; it += NGW) {
        const int b = it >> 6, n = it & 63; const int f = F.lane * 4;
        const float* src = KV + ((size_t)b * SEQ + n * 32) * 768 + f; const float* w = INF(14) + (f >> 7) * 4096 + (f & 127);
        f32x4 acc = {0.f, 0.f, 0.f, 0.f};
#pragma unroll 8
        for (int j = 0; j < 32; ++j) acc += *(const f32x4*)(src + (size_t)j * 768) * *(const f32x4*)(w + j * 128);
        *(f32x4*)(KVCP + (size_t)it * 256 + f) = acc;
        { f16x4 o; o[0] = (f16)acc[0]; o[1] = (f16)acc[1]; o[2] = (f16)acc[2]; o[3] = (f16)acc[3]; *(f16x4*)(WSP(f16, WS_KVC16) + (size_t)it * 256 + f) = o; }
    }
}
__device__ __forceinline__ void phase_conv4(Frame& F) {
    const f16* U = WSP(f16, WS_U16C); f16* UC16 = WSP(f16, WS_UC16);
    const int gt = F.bid * NTHREADS + F.tid, NGT = F.nb * NTHREADS;
    for (int i = gt; i < MT * 128; i += NGT) {
        const int row = i >> 7, c8 = (i & 127) * 8;
        int t, b; bool samp = row >= MP;
        if (!samp) { b = row >> 11; t = row & 2047; } else { const int s = row - MP; b = s >> 2; t = s & 3; }
        float acc[8];
#pragma unroll
        for (int e = 0; e < 8; ++e) acc[e] = INF(18)[c8 + e];
#pragma unroll
        for (int k = 0; k < 4; ++k) {
            const int tt = t - 3 + k; const float* w = INF(17) + (size_t)k * D + c8;
            if (tt >= 0) { const f16x8 u = *(const f16x8*)(U + (size_t)(row - 3 + k) * D + c8);
#pragma unroll
                for (int e = 0; e < 8; ++e) acc[e] += w[e] * (float)u[e]; }
            else if (samp) { const float* st = INF(6) + ((size_t)b * 3 + (3 + tt)) * D + c8;
#pragma unroll
                for (int e = 0; e < 8; ++e) acc[e] += w[e] * st[e]; }
        }
        f16x8 o;
#pragma unroll
        for (int e = 0; e < 8; ++e) o[e] = (f16)acc[e];
        *(f16x8*)(UC16 + (size_t)row * D + c8) = o;
    }
}
__device__ __forceinline__ void phase_scan(Frame& F) {
    const float* RI = WSP(float, WS_RI32); const float* UC = WSP(float, WS_UC32); const f16* SZ = WSP(f16, WS_SZ16); f16* YH = WSP(f16, WS_YH);
    const int gt = F.bid * NTHREADS + F.tid, NGT = F.nb * NTHREADS;
    for (int i = gt; i < (BATCH + DEC_B) * D; i += NGT) {
        const int sq = i >> 10, ch = i & 1023;
        const bool samp = sq >= BATCH; const int b = samp ? sq - BATCH : sq;
        const int T = samp ? DEC_T : SEQ; const size_t r0 = samp ? (size_t)MP + b * DEC_T : (size_t)b * SEQ;
        float h = samp ? INF(5)[(size_t)b * D + ch] : 0.f;
        const float cl = -8.f * log1pf(__expf(-INF(23)[ch])); const float ba = INF(20)[ch], bx = INF(22)[ch];
        for (int t = 0; t < T; ++t) {
            const size_t row = r0 + t;
            const float r = sigmoidf_(RI[row * 2048 + ch] + ba), ig = sigmoidf_(RI[row * 2048 + 1024 + ch] + bx);
            const float la = cl * r, a = __expf(la), bq = sqrtf(-expm1f(2.f * la)) * (ig * UC[row * D + ch]);
            h = a * h + bq;
            YH[row * D + ch] = (f16)((float)SZ[row * D + ch] * h);
        }
        if (samp) F.out[O_HS + (size_t)b * D + ch] = h; else F.out[O_HP + (size_t)b * D + ch] = h;
    }
}

struct KeyRef { const float* k; const float* v; int pos; bool valid; };
constexpr int AT_QS = 0, AT_SC = AT_QS + 8 * 64 * 4, AT_PC = AT_SC + 8 * 1088 * 4, AT_IMP = AT_PC + 8 * 264 * 4, AT_SEL = AT_IMP + 136 * 4, AT_END = AT_SEL + 64;
template <class KF>
__device__ __forceinline__ float attn_branch(Frame& F, int nkeys, const KF& kf, float slope, int t, LAS const float* qs, LAS float* sc, LAS float* pcout) {
    float mloc = -1e30f;
    for (int j0 = 0; j0 < nkeys; j0 += 64) {
        const int j = j0 + F.lane; float s = -1e30f;
        if (j < nkeys) { const KeyRef kr = kf(j);
            if (kr.valid) { float acc = 0.f;
#pragma unroll
                for (int d4 = 0; d4 < 16; ++d4) { const f32x4 kk = *(const f32x4*)(kr.k + 4 * d4); const f32x4 qq = *(LAS const f32x4*)(qs + 4 * d4); acc += kk[0] * qq[0] + kk[1] * qq[1] + kk[2] * qq[2] + kk[3] * qq[3]; }
                s = acc - slope * (float)(t - kr.pos); }
            sc[j] = s; }
        mloc = fmaxf(mloc, s);
    }
    const float m = wave_max(mloc);
    float lloc = 0.f;
    for (int j0 = 0; j0 < nkeys; j0 += 64) { const int j = j0 + F.lane; if (j < nkeys) { const float s = sc[j]; const float p = (s > -1e29f) ? exp2f(s - m) : 0.f; sc[j] = p; lloc += p; } }
    const float l = wave_sum(lloc);
    const float inv = (l > 0.f) ? 1.f / l : 0.f;
    if (pcout) for (int j0 = 0; j0 < nkeys; j0 += 64) { const int j = j0 + F.lane; if (j < nkeys) pcout[j] = sc[j] * inv; }
    asm volatile("s_waitcnt lgkmcnt(0)" ::: "memory");
    float o = 0.f;
    for (int j = 0; j < nkeys; ++j) { const float p = sc[j]; if (p != 0.f) { const KeyRef kr = kf(j); o += p * kr.v[F.lane]; } }
    return o * inv;
}
__device__ __forceinline__ void phase_attn_sample(Frame& F) {
    const f16* Q = WSP(f16, WS_Q16); const float* KV = WSP(float, WS_KV32); const float* G = WSP(float, WS_GATES); const f16* SZ = WSP(f16, WS_SZ16); f16* OG = WSP(f16, WS_OG);
    const float* KVCP = WSP(float, WS_KVCP); const float* KVCS = WSP(float, WS_KVCS);
    LAS float* qs = (LAS float*)(F.lds + AT_QS) + F.wave * 64; LAS float* sc = (LAS float*)(F.lds + AT_SC) + F.wave * 1088; LAS float* pc = (LAS float*)(F.lds + AT_PC) + F.wave * 264;
    LAS float* pcall = (LAS float*)(F.lds + AT_PC); LAS float* imp = (LAS float*)(F.lds + AT_IMP); LAS int* sel = (LAS int*)(F.lds + AT_SEL);
    const int hh = F.wave;
    for (int it = MP * 2 + F.bid; it < MT * 2; it += F.nb) {
        const int row = it >> 1, g = it & 1, head = g * 8 + hh;
        const bool samp = row >= MP; int b, tq;
        if (!samp) { b = row >> 11; tq = row & 2047; } else { const int s = row - MP; b = s >> 2; tq = s & 3; }
        const int t = samp ? PAST + tq : tq;
        const float slope = exp2f(-0.5f * (float)(head + 1)) * LOG2E;
        qs[F.lane] = (float)Q[(size_t)row * D + head * 64 + F.lane];
        const int ncmp = samp ? 256 : (t + 1) / 32;
        for (int j = F.lane; j < 264; j += 64) pc[j] = 0.f;
        asm volatile("s_waitcnt lgkmcnt(0)" ::: "memory");
        const float* kvc = samp ? KVCS + (size_t)b * 256 * 256 : KVCP + (size_t)b * 64 * 256;
        auto kf_c = [&](int j) { KeyRef r; r.k = kvc + (size_t)j * 256 + g * 64; r.v = kvc + (size_t)j * 256 + 128 + g * 64; r.pos = 32 * j + 31; r.valid = true; return r; };
        const float o_c = (ncmp > 0) ? attn_branch(F, ncmp, kf_c, slope, t, qs, sc, pc) : 0.f;
        __syncthreads();
        const int nslc = samp ? 129 : 32, cur = t >> 6;
        if (F.tid < nslc) { const int blk = F.tid; float s = 0.f;
#pragma unroll
            for (int h2 = 0; h2 < 8; ++h2) s += pcall[h2 * 264 + 2 * blk] + pcall[h2 * 264 + 2 * blk + 1];
            const bool forced = (blk == 0) || (blk <= cur && blk > cur - 2);
            imp[blk] = forced ? 1e9f : (blk <= cur ? s : -1e30f); }
        __syncthreads();
        if (F.tid < nslc) { const float my = imp[F.tid]; int rank = 0;
            for (int j = 0; j < nslc; ++j) { const float o = imp[j]; rank += (o > my || (o == my && j < F.tid)) ? 1 : 0; }
            if (rank < 16) sel[rank] = F.tid; }
        __syncthreads();
        const int* pt = ((const int*)F.ap->in[7]) + b * NPAGES;
        auto kf_s = [&](int j) { KeyRef r; const int blk = sel[j >> 6]; const int pos = blk * 64 + (j & 63); r.pos = pos; r.valid = pos <= t; r.k = KV; r.v = KV;
            if (r.valid) { if (!samp) { const float* p = KV + ((size_t)b * SEQ + pos) * 768; r.k = p + 256 + g * 64; r.v = p + 384 + g * 64; }
                else if (pos < PAST) { const float* p = INF(2) + ((size_t)pt[pos >> 7] * PAGE + (pos & 127)) * 512; r.k = p + 256 + g * 64; r.v = p + 384 + g * 64; }
                else { const float* p = KV + ((size_t)MP + b * DEC_T + (pos - PAST)) * 768; r.k = p + 256 + g * 64; r.v = p + 384 + g * 64; } }
            return r; };
        const float o_s = attn_branch(F, 1024, kf_s, slope, t, qs, sc, (LAS float*)nullptr);
        auto kf_w = [&](int j) { KeyRef r; r.k = KV; r.v = KV;
            if (!samp) { const int pos = t - 511 + j; r.pos = pos; r.valid = pos >= 0; if (r.valid) { const float* p = KV + ((size_t)b * SEQ + pos) * 768; r.k = p + 512 + g * 64; r.v = p + 640 + g * 64; } }
            else { const int w = tq + 1 + j; r.pos = PAST - 512 + w; r.valid = true;
                if (w < 512) { const float* p = INF(3) + ((size_t)b * 512 + w) * 256; r.k = p + g * 64; r.v = p + 128 + g * 64; }
                else { const float* p = KV + ((size_t)MP + b * DEC_T + (w - 512)) * 768; r.k = p + 512 + g * 64; r.v = p + 640 + g * 64; } }
            return r; };
        const float o_w = attn_branch(F, 512, kf_w, slope, t, qs, sc, (LAS float*)nullptr);
        const float* gr = G + (size_t)row * 48 + g * 8 + hh;
        const float o = gr[0] * o_c + gr[16] * o_s + gr[32] * o_w;
        OG[(size_t)row * D + head * 64 + F.lane] = (f16)(o * (float)SZ[(size_t)row * D + head * 64 + F.lane]);
        __syncthreads();
    }
}


typedef float f32x16 __attribute__((ext_vector_type(16)));
typedef short v4i16_t __attribute__((ext_vector_type(4)));
constexpr int PA_K = 0, PA_V = 16384, PA_WSF = 32768, PA_IMPS = 34816, PA_SC = PA_IMPS + 8 * 32 * 33 * 4, PA_SELM = PA_SC + 32 * 33 * 4, PA_END = PA_SELM + 128, PA_ACC = 73728;
__device__ __forceinline__ int crow(int r, int hi) { return (r & 3) + 8 * (r >> 2) + 4 * hi; }
__device__ __forceinline__ float swap_half(float v) { auto rr = __builtin_amdgcn_permlane32_swap(__float_as_uint(v), __float_as_uint(v), false, false); return __uint_as_float(hipThreadIdx_x & 32 ? rr[0] : rr[1]); }
struct TileSrc { const f16* k; const f16* v; int stride; };
__device__ __forceinline__ void pa_load(const TileSrc& s, int wid, int lane, u32x4& kr, u32x4& vr) {
    kr = *(const u32x4*)(s.k + (size_t)lane * s.stride + wid * 8);
    vr = *(const u32x4*)(s.v + (size_t)(16 * (wid & 3) + (lane >> 2)) * s.stride + (wid >> 2) * 32 + (lane & 3) * 8);
}
__device__ __forceinline__ void pa_store(LAS unsigned char* lds, int buf, int wid, int lane, u32x4 kr, u32x4 vr) {
    *(LAS u32x4*)(lds + PA_K + buf * 8192 + wid * 1024 + lane * 16) = kr;
    *(LAS u32x4*)(lds + PA_V + buf * 8192 + wid * 1024 + lane * 16) = vr;
}
__device__ __forceinline__ void pa_tile(LAS const unsigned char* Kb, LAS const unsigned char* Vb, const f16x8 (&qr)[4], float slope2, float kpos0, float kstep,
                                        bool masked, float hi_lim, float lo_lim, bool dead, float& m, float& l, f32x16 (&o)[2], LAS float* wsf, LAS float* imp_row, float imp_inv, int lane) {
    const int r32 = lane & 31, hi = lane >> 5;
    f32x16 p0, p1;
    if (masked) {
#pragma unroll
        for (int r = 0; r < 16; ++r) { const float pos = kpos0 + kstep * (float)crow(r, hi), pos1 = pos + 32.f * kstep;
            const bool k0 = dead || pos > hi_lim || pos < lo_lim, k1 = dead || pos1 > hi_lim || pos1 < lo_lim;
            p0[r] = k0 ? -INFINITY : slope2 * pos; p1[r] = k1 ? -INFINITY : slope2 * pos1; }
    } else {
#pragma unroll
        for (int r = 0; r < 16; ++r) { const float pos = kpos0 + kstep * (float)crow(r, hi); p0[r] = slope2 * pos; p1[r] = slope2 * (pos + 32.f * kstep); }
    }
    LAS const unsigned char* kb = Kb + hi * 1024 + r32 * 16;
#pragma unroll
    for (int d0 = 0; d0 < 4; ++d0) {
        const f16x8 b0 = *(LAS const f16x8*)(kb + d0 * 2048), b1 = *(LAS const f16x8*)(kb + d0 * 2048 + 512);
        p0 = __builtin_amdgcn_mfma_f32_32x32x16_f16(b0, qr[d0], p0, 0, 0, 0);
        p1 = __builtin_amdgcn_mfma_f32_32x32x16_f16(b1, qr[d0], p1, 0, 0, 0);
    }
    float rm = fmaxf(p0[0], p1[0]);
#pragma unroll
    for (int r = 1; r < 16; ++r) rm = fmaxf(rm, fmaxf(p0[r], p1[r]));
    rm = fmaxf(rm, swap_half(rm));
    const float mn = fmaxf(m, rm), f = __builtin_amdgcn_exp2f(m - mn); m = mn;
    float ps = 0.f;
#pragma unroll
    for (int r = 0; r < 16; ++r) { p0[r] = __builtin_amdgcn_exp2f(p0[r] - mn); p1[r] = __builtin_amdgcn_exp2f(p1[r] - mn); ps += p0[r] + p1[r]; }
    l = l * f + ps;
    if (imp_row) {
        float inv = imp_inv;
        if (imp_inv < 0.f) { const float lt = ps + swap_half(ps); inv = lt > 0.f ? 1.f / lt : 0.f; }
        LAS float* base = imp_row + 2 * hi;
#pragma unroll
        for (int a = 0; a < 4; ++a) { base[4 * a] = (p0[4 * a] + p0[4 * a + 1]) * inv; base[4 * a + 1] = (p0[4 * a + 2] + p0[4 * a + 3]) * inv;
            base[16 + 4 * a] = (p1[4 * a] + p1[4 * a + 1]) * inv; base[16 + 4 * a + 1] = (p1[4 * a + 2] + p1[4 * a + 3]) * inv; }
    }
    if (hi == 0) wsf[r32] = f;
#pragma unroll
    for (int r = 0; r < 16; ++r) { const float fr_ = wsf[crow(r, hi)]; o[0][r] *= fr_; o[1][r] *= fr_; }
    f16x8 pa[4];
#pragma unroll
    for (int j = 0; j < 8; ++j) { pa[0][j] = (f16)p0[j]; pa[1][j] = (f16)p0[8 + j]; pa[2][j] = (f16)p1[j]; pa[3][j] = (f16)p1[8 + j]; }
    LAS const unsigned char* vp = Vb + ((lane >> 4) & 1) * 32 + (lane & 3) * 8 + (4 * hi + ((lane & 15) >> 2)) * 64;
#pragma unroll
    for (int d0 = 0; d0 < 2; ++d0)
#pragma unroll
        for (int ks = 0; ks < 4; ++ks) {
            const f16x4 lo = __builtin_bit_cast(f16x4, __builtin_amdgcn_ds_read_tr16_b64_v4i16((LAS v4i16_t*)(vp + d0 * 4096 + ks * 1024)));
            const f16x4 hh = __builtin_bit_cast(f16x4, __builtin_amdgcn_ds_read_tr16_b64_v4i16((LAS v4i16_t*)(vp + d0 * 4096 + ks * 1024 + 512)));
            const f16x8 vf = {lo[0], lo[1], lo[2], lo[3], hh[0], hh[1], hh[2], hh[3]};
            o[d0] = __builtin_amdgcn_mfma_f32_32x32x16_f16(pa[ks], vf, o[d0], 0, 0, 0);
        }
}
__device__ __forceinline__ void pa_unit(Frame& F, int b, int g, int qt) {
    const int lane = F.lane, wid = F.wave, r32 = lane & 31, hi = lane >> 5, head = g * 8 + wid;
    const int t0 = qt * 32, tq = t0 + r32, cur = t0 >> 6; const float tqf = (float)tq;
    const size_t rowb = (size_t)b * SEQ;
    const float slope2 = exp2f(-0.5f * (float)(head + 1)) * LOG2E;
    const f16* Q = WSP(f16, WS_Q16); const f16* KV16 = WSP(f16, WS_KV16); const f16* KVC = WSP(f16, WS_KVC16); const float* G = WSP(float, WS_GATES); const f16* SZ = WSP(f16, WS_SZ16); f16* OG = WSP(f16, WS_OG);
    LAS unsigned char* lds = F.lds;
    LAS float* wsf = (LAS float*)(lds + PA_WSF) + wid * 64; LAS float* IMPS = (LAS float*)(lds + PA_IMPS); LAS float* SC = (LAS float*)(lds + PA_SC); LAS unsigned* SELM = (LAS unsigned*)(lds + PA_SELM);
    f16x8 qr[4];
#pragma unroll
    for (int d0 = 0; d0 < 4; ++d0) qr[d0] = *(const f16x8*)(Q + (rowb + tq) * D + head * 64 + d0 * 16 + hi * 8);
    f32x16 o[2];
    LAS float* accl = (LAS float*)(lds + PA_ACC) + wid * 2048 + lane;
#pragma unroll
    for (int r = 0; r < 16; ++r) { accl[r * 64] = 0.f; accl[(16 + r) * 64] = 0.f; o[0][r] = 0.f; o[1][r] = 0.f; }
    float m = -1e30f, l = 0.f;
    auto finalize = [&](int br) {
        const float lt = l + swap_half(l), inv = lt > 0.f ? 1.f / lt : 0.f;
        if (hi == 0) wsf[r32] = inv * G[(rowb + tq) * 48 + br * 16 + g * 8 + wid];
#pragma unroll
        for (int r = 0; r < 16; ++r) { const int qrow = crow(r, hi); const float sc_ = wsf[qrow];
            accl[r * 64] += o[0][r] * sc_; accl[(16 + r) * 64] += o[1][r] * sc_; o[0][r] = 0.f; o[1][r] = 0.f; }
        m = -1e30f; l = 0.f;
    };
    u32x4 kr, vr;
    { TileSrc ts{KVC + (size_t)b * 64 * 256 + g * 64, KVC + (size_t)b * 64 * 256 + 128 + g * 64, 256};
      pa_load(ts, wid, lane, kr, vr); pa_store(lds, 0, wid, lane, kr, vr); if (F.tid < 32) SELM[F.tid] = 0u; }
    __syncthreads();
    pa_tile(lds + PA_K, lds + PA_V, qr, slope2, 31.f, 32.f, true, tqf, -1e30f, false, m, l, o, wsf, IMPS + wid * 32 * 33 + r32 * 33, -1.f, lane);
    finalize(0);
    __syncthreads();
    { const int q = F.tid >> 4, bb = (F.tid & 15) * 2;
#pragma unroll
      for (int e = 0; e < 2; ++e) { const int blk = bb + e; float s_ = 0.f;
#pragma unroll
          for (int w = 0; w < 8; ++w) s_ += IMPS[(w * 32 + q) * 33 + blk];
          const bool forced = (blk == 0) || (blk <= cur && blk > cur - 2);
          SC[q * 33 + blk] = forced ? 1e9f : (blk <= cur ? s_ : -1e30f); }
      __syncthreads();
#pragma unroll
      for (int e = 0; e < 2; ++e) { const int blk = bb + e; const float my = SC[q * 33 + blk]; int rank = 0;
          for (int j = 0; j < 32; ++j) { const float ov = SC[q * 33 + j]; rank += (ov > my || (ov == my && j < blk)) ? 1 : 0; }
          if (rank < 16) atomicOr((unsigned*)&SELM[q], 1u << blk); }
      __syncthreads(); }
    const unsigned mysel = SELM[r32];
    unsigned un = mysel;
#pragma unroll
    for (int ofs = 1; ofs < 32; ofs <<= 1) un |= (unsigned)__shfl_xor((int)un, ofs);
    un = (unsigned)__builtin_amdgcn_readfirstlane((int)un);
    unsigned rem = un & (cur >= 31 ? 0xffffffffu : ((2u << cur) - 1u));
    int jw = (t0 - 511) > 0 ? ((t0 - 511) >> 6) : 0;
    const f16* kvb = KV16 + rowb * 768 + g * 64;
    int kind, j;
    { kind = 1; j = __builtin_ctz(rem); rem &= rem - 1u; }
    { TileSrc ts{kvb + (size_t)64 * j * 768 + 256, kvb + (size_t)64 * j * 768 + 384, 768}; pa_load(ts, wid, lane, kr, vr); pa_store(lds, 0, wid, lane, kr, vr); }
    __syncthreads();
    int buf = 0, curkind = 1;
    for (;;) {
        int nkind, nj;
        if (rem) { nkind = 1; nj = __builtin_ctz(rem); rem &= rem - 1u; } else if (jw <= cur) { nkind = 2; nj = jw++; } else { nkind = 3; nj = 0; }
        if (nkind != 3) { const int co = nkind == 1 ? 256 : 512; TileSrc ts{kvb + (size_t)64 * nj * 768 + co, kvb + (size_t)64 * nj * 768 + co + 128, 768}; pa_load(ts, wid, lane, kr, vr); }
        if (kind != curkind) { finalize(1); curkind = kind; }
        const bool diag = (j == cur);
        if (kind == 1) pa_tile(lds + PA_K + buf * 8192, lds + PA_V + buf * 8192, qr, slope2, (float)(64 * j), 1.f, true, diag ? tqf : 1e30f, -1e30f, !((mysel >> j) & 1u), m, l, o, wsf, (LAS float*)nullptr, 0.f, lane);
        else { const bool left = (64 * j < t0 - 480);
               pa_tile(lds + PA_K + buf * 8192, lds + PA_V + buf * 8192, qr, slope2, (float)(64 * j), 1.f, diag || left, diag ? tqf : 1e30f, left ? tqf - 511.f : -1e30f, false, m, l, o, wsf, (LAS float*)nullptr, 0.f, lane); }
        if (nkind != 3) pa_store(lds, buf ^ 1, wid, lane, kr, vr);
        __syncthreads();
        if (nkind == 3) break;
        buf ^= 1; kind = nkind; j = nj;
    }
    finalize(2);
#pragma unroll 1
    for (int r = 0; r < 16; ++r) { const size_t row = rowb + t0 + crow(r, hi);
#pragma unroll
        for (int d0 = 0; d0 < 2; ++d0) { const size_t idx = row * D + head * 64 + 32 * d0 + r32; OG[idx] = (f16)(accl[(16 * d0 + r) * 64] * (float)SZ[idx]); } }
    __syncthreads();
}
__device__ __forceinline__ void phase_attn_prompt(Frame& F) {
    const bool bal = (F.nb == 256); const int bg = F.bid >> 4, s_ = F.bid & 15;
#pragma unroll 1
    for (int i = 0; ; ++i) {
        int b, g, qt;
        if (bal) { if (i >= 4) break; qt = (i == 0) ? s_ : (i == 1) ? 31 - s_ : (i == 2) ? 32 + s_ : 63 - s_; b = bg >> 1; g = bg & 1; }
        else { const int u = F.bid + i * F.nb; if (u >= BATCH * 2 * 64) break; b = u >> 7; g = (u >> 6) & 1; qt = u & 63; }
        pa_unit(F, b, g, qt);
    }
}


constexpr int SA_IMPS = PA_IMPS, SA_SC = PA_SC, SA_SELM = PA_SELM, SA_QSTRIDE = 132;
__device__ __forceinline__ u32x4 ld_cvt8(const float* p) {
    f16x8 o;
    if (p) { const f32x4 a = *(const f32x4*)p, b = *(const f32x4*)(p + 4); o[0] = (f16)a[0]; o[1] = (f16)a[1]; o[2] = (f16)a[2]; o[3] = (f16)a[3]; o[4] = (f16)b[0]; o[5] = (f16)b[1]; o[6] = (f16)b[2]; o[7] = (f16)b[3]; }
    else { o = (f16x8){0, 0, 0, 0, 0, 0, 0, 0}; }
    return __builtin_bit_cast(u32x4, o);
}
__device__ __forceinline__ void pa_stats(LAS const unsigned char* Kb, const f16x8 (&qr)[4], float slope2, float kpos0, float kstep, float& m, float& l, int lane) {
    const int r32 = lane & 31, hi = lane >> 5;
    f32x16 p0, p1;
#pragma unroll
    for (int r = 0; r < 16; ++r) { const float pos = kpos0 + kstep * (float)crow(r, hi); p0[r] = slope2 * pos; p1[r] = slope2 * (pos + 32.f * kstep); }
    LAS const unsigned char* kb = Kb + hi * 1024 + r32 * 16;
#pragma unroll
    for (int d0 = 0; d0 < 4; ++d0) {
        const f16x8 b0 = *(LAS const f16x8*)(kb + d0 * 2048), b1 = *(LAS const f16x8*)(kb + d0 * 2048 + 512);
        p0 = __builtin_amdgcn_mfma_f32_32x32x16_f16(b0, qr[d0], p0, 0, 0, 0);
        p1 = __builtin_amdgcn_mfma_f32_32x32x16_f16(b1, qr[d0], p1, 0, 0, 0);
    }
    float rm = fmaxf(p0[0], p1[0]);
#pragma unroll
    for (int r = 1; r < 16; ++r) rm = fmaxf(rm, fmaxf(p0[r], p1[r]));
    rm = fmaxf(rm, swap_half(rm));
    const float mn = fmaxf(m, rm), f = __builtin_amdgcn_exp2f(m - mn); m = mn;
    float ps = 0.f;
#pragma unroll
    for (int r = 0; r < 16; ++r) ps += __builtin_amdgcn_exp2f(p0[r] - mn) + __builtin_amdgcn_exp2f(p1[r] - mn);
    l = l * f + ps;
}
__device__ __forceinline__ void sa_item(Frame& F, int b, int g) {
    const int lane = F.lane, wid = F.wave, r32 = lane & 31, hi = lane >> 5, head = g * 8 + wid, qi = r32 & 3;
    const float tqf = (float)(PAST + qi);
    const float slope2 = exp2f(-0.5f * (float)(head + 1)) * LOG2E;
    const f16* Q = WSP(f16, WS_Q16); const float* KV = WSP(float, WS_KV32); const float* KVCS = WSP(float, WS_KVCS); const float* G = WSP(float, WS_GATES); const f16* SZ = WSP(f16, WS_SZ16); f16* OG = WSP(f16, WS_OG);
    const float* cache_kv = INF(2); const float* cache_win = INF(3); const int* pt = (const int*)F.ap->in[7] + b * NPAGES;
    LAS unsigned char* lds = F.lds;
    LAS float* wsf = (LAS float*)(lds + PA_WSF) + wid * 64; LAS float* IMPS = (LAS float*)(lds + SA_IMPS); LAS float* SC = (LAS float*)(lds + SA_SC); LAS unsigned* SELM = (LAS unsigned*)(lds + SA_SELM);
    const size_t qrow = (size_t)MP + 4 * b + qi;
    f16x8 qr[4];
#pragma unroll
    for (int d0 = 0; d0 < 4; ++d0) qr[d0] = *(const f16x8*)(Q + qrow * D + head * 64 + d0 * 16 + hi * 8);
    f32x16 o[2];
    LAS float* accl = (LAS float*)(lds + PA_ACC) + wid * 2048 + lane;
#pragma unroll
    for (int r = 0; r < 16; ++r) { accl[r * 64] = 0.f; accl[(16 + r) * 64] = 0.f; o[0][r] = 0.f; o[1][r] = 0.f; }
    float m = -1e30f, l = 0.f;
    auto finalize = [&](int br) {
        const float lt = l + swap_half(l), inv = lt > 0.f ? 1.f / lt : 0.f;
        if (hi == 0) wsf[r32] = inv * G[qrow * 48 + br * 16 + g * 8 + wid];
#pragma unroll
        for (int r = 0; r < 16; ++r) { const float sc_ = wsf[crow(r, hi)]; accl[r * 64] += o[0][r] * sc_; accl[(16 + r) * 64] += o[1][r] * sc_; o[0][r] = 0.f; o[1][r] = 0.f; }
        m = -1e30f; l = 0.f;
    };
    auto load_tile = [&](int kind, int j) {
        const int krow = lane, vrow = 16 * (wid & 3) + (lane >> 2), kcol = wid * 8, vcol = (wid >> 2) * 32 + (lane & 3) * 8;
        const float *kp = nullptr, *vp = nullptr;
        if (kind == 0) { const float* base = KVCS + ((size_t)b * 256 + 64 * j) * 256 + g * 64; kp = base + (size_t)krow * 256 + kcol; vp = base + (size_t)vrow * 256 + 128 + vcol; }
        else if (kind == 1) {
            if (j < 128) { const float* base = cache_kv + ((size_t)pt[j >> 1] * PAGE + (j & 1) * 64) * 512 + 256 + g * 64; kp = base + (size_t)krow * 512 + kcol; vp = base + (size_t)vrow * 512 + 128 + vcol; }
            else { const float* base = KV + ((size_t)MP + 4 * b) * 768 + 256 + g * 64; if (krow < 4) kp = base + (size_t)krow * 768 + kcol; if (vrow < 4) vp = base + (size_t)vrow * 768 + 128 + vcol; } }
        else { const int wk = 64 * j + krow, wv = 64 * j + vrow;
            if (wk < 512) kp = cache_win + ((size_t)b * 512 + wk) * 256 + g * 64 + kcol; else if (wk < 516) kp = KV + ((size_t)MP + 4 * b + (wk - 512)) * 768 + 512 + g * 64 + kcol;
            if (wv < 512) vp = cache_win + ((size_t)b * 512 + wv) * 256 + 128 + g * 64 + vcol; else if (wv < 516) vp = KV + ((size_t)MP + 4 * b + (wv - 512)) * 768 + 640 + g * 64 + vcol; }
        const u32x4 kr = ld_cvt8(kp), vr = ld_cvt8(vp);
        pa_store(lds, 0, wid, lane, kr, vr);
    };
    if (F.tid < 32) SELM[F.tid] = 0u;
#pragma unroll 1
    for (int j = 0; j < 4; ++j) { load_tile(0, j); __syncthreads(); pa_stats(lds + PA_K, qr, slope2, (float)(2048 * j + 31), 32.f, m, l, lane); __syncthreads(); }
    { const float lt = l + swap_half(l); const float inv = lt > 0.f ? 1.f / lt : 0.f; l = 0.f;
#pragma unroll 1
      for (int j = 0; j < 4; ++j) { load_tile(0, j); __syncthreads();
          pa_tile(lds + PA_K, lds + PA_V, qr, slope2, (float)(2048 * j + 31), 32.f, false, 0.f, 0.f, false, m, l, o, wsf, IMPS + (wid * 4 + qi) * SA_QSTRIDE + 32 * j, inv, lane);
          __syncthreads(); } }
    finalize(0);
    { const int q = F.tid >> 7, blk = F.tid & 127; float s_ = 0.f;
#pragma unroll
      for (int w = 0; w < 8; ++w) s_ += IMPS[(w * 4 + q) * SA_QSTRIDE + blk];
      SC[q * SA_QSTRIDE + blk] = (blk == 0 || blk == 127) ? 1e9f : s_;
      __syncthreads();
      const float my = SC[q * SA_QSTRIDE + blk]; int rank = (my < 1e9f) ? 1 : 0;
      for (int j2 = 0; j2 < 128; ++j2) { const float ov = SC[q * SA_QSTRIDE + j2]; rank += (ov > my || (ov == my && j2 < blk)) ? 1 : 0; }
      if (rank < 16) atomicOr((unsigned*)&SELM[q * 8 + (blk >> 5)], 1u << (blk & 31));
      if (blk == 0) SELM[q * 8 + 4] = 1u;
      __syncthreads(); }
    unsigned mysel[5], un[5];
#pragma unroll
    for (int w = 0; w < 5; ++w) { mysel[w] = SELM[qi * 8 + w]; un[w] = (unsigned)__builtin_amdgcn_readfirstlane((int)(SELM[w] | SELM[8 + w] | SELM[16 + w] | SELM[24 + w])); }
#pragma unroll
    for (int w = 0; w < 5; ++w) {
        unsigned rem = un[w];
#pragma unroll 1
        while (rem) { const int bit = __builtin_ctz(rem); rem &= rem - 1u; const int j = 32 * w + bit;
            load_tile(1, j); __syncthreads();
            pa_tile(lds + PA_K, lds + PA_V, qr, slope2, (float)(64 * j), 1.f, true, tqf, -1e30f, !((mysel[w] >> bit) & 1u), m, l, o, wsf, (LAS float*)nullptr, 0.f, lane);
            __syncthreads(); }
    }
    finalize(1);
#pragma unroll 1
    for (int j = 0; j < 9; ++j) { load_tile(2, j); __syncthreads();
        pa_tile(lds + PA_K, lds + PA_V, qr, slope2, (float)(PAST - 512 + 64 * j), 1.f, true, tqf, tqf - 511.f, false, m, l, o, wsf, (LAS float*)nullptr, 0.f, lane);
        __syncthreads(); }
    finalize(2);
    if (hi == 0) {
#pragma unroll
        for (int r = 0; r < 4; ++r)
#pragma unroll
            for (int d0 = 0; d0 < 2; ++d0) { const size_t idx = ((size_t)MP + 4 * b + r) * D + head * 64 + 32 * d0 + r32; OG[idx] = (f16)(accl[(16 * d0 + r) * 64] * (float)SZ[idx]); }
    }
    __syncthreads();
}
__device__ __forceinline__ void phase_attn_sample_mfma(Frame& F) {
#pragma unroll 1
    for (int it = F.bid; it < DEC_B * 2; it += F.nb) sa_item(F, it >> 1, it & 1);
}

constexpr int SC_WG = 0, SC_WROW = 528, SC_COMP = 2 * 32 * SC_WROW, SC_TILE = SC_COMP + 2 * 8 * 32 * 2 * 4, SC_END = SC_TILE + 8 * 6144;
__device__ __forceinline__ float neg_expm1_small(float x) {
    return -x * (1.f + x * 0.5f * (1.f + x * (1.f / 3.f) * (1.f + x * 0.25f * (1.f + x * 0.2f))));
}
__device__ __forceinline__ void gate_ab(float rpre, float ipre, float ucv, float ba, float bx, float cl, float& a, float& bq) {
    const float rr = 1.f / (1.f + __builtin_amdgcn_exp2f(-LOG2E * (rpre + ba))), ii = 1.f / (1.f + __builtin_amdgcn_exp2f(-LOG2E * (ipre + bx)));
    const float la = cl * rr; a = __builtin_amdgcn_exp2f(LOG2E * la);
    bq = __builtin_amdgcn_sqrtf(neg_expm1_small(2.f * la)) * (ii * ucv);
}
__device__ __forceinline__ void scan_prompt_item(Frame& F, int b, int cgrp) {
    const int lane = F.lane, wid = F.wave, c = lane & 31, hi = lane >> 5;
    const int cg = cgrp * 32 + c, n = cgrp >> 3;
    const f16* UC = WSP(f16, WS_UC16); const f16* SZ = WSP(f16, WS_SZ16); f16* YH = WSP(f16, WS_YH); const f16* WG = WSP(f16, WS_WC_G);
    LAS unsigned char* lds = F.lds;
    for (int i = F.tid; i < 64 * 32; i += NTHREADS) { const int rw = i >> 5, ch16 = i & 31;
        const f16* src = WG + (size_t)((rw >> 5) * 1024 + cgrp * 32 + (rw & 31)) * 256 + ch16 * 8;
        *(LAS u32x4*)(lds + SC_WG + rw * SC_WROW + ch16 * 16) = *(const u32x4*)src; }
    const float ba = INF(20)[cg], bx = INF(22)[cg], cl = -8.f * log1pf(__expf(-INF(23)[cg]));
    __syncthreads();
    const size_t rowb = (size_t)b * SEQ;
    float hstep = 0.f;
    LAS float* COMP = (LAS float*)(lds + SC_COMP);
    LAS f16* tUC = (LAS f16*)(lds + SC_TILE + wid * 6144); LAS f16* tSZ = tUC + 1024; LAS f16* tYH = tUC + 2048;
    LAS const unsigned char* wr_ = lds + SC_WG + c * SC_WROW + hi * 16; LAS const unsigned char* wx_ = wr_ + 32 * SC_WROW;
#pragma unroll 1
    for (int step = 0; step < SEQ / 256; ++step) {
        const int tw0 = step * 256 + wid * 32;
        f32x16 accR, accI;
#pragma unroll
        for (int r = 0; r < 16; ++r) { accR[r] = 0.f; accI[r] = 0.f; }
        const f16* ap = UC + (rowb + tw0 + c) * D + n * 256 + hi * 8;
        { const size_t go = (rowb + tw0 + (lane >> 1)) * D + cgrp * 32 + (lane & 1) * 16;
          const u32x4 u0 = *(const u32x4*)(UC + go), u1 = *(const u32x4*)(UC + go + 8), z0 = *(const u32x4*)(SZ + go), z1 = *(const u32x4*)(SZ + go + 8);
          *(LAS u32x4*)((LAS unsigned char*)tUC + lane * 32) = u0; *(LAS u32x4*)((LAS unsigned char*)tUC + lane * 32 + 16) = u1;
          *(LAS u32x4*)((LAS unsigned char*)tSZ + lane * 32) = z0; *(LAS u32x4*)((LAS unsigned char*)tSZ + lane * 32 + 16) = z1; }
#pragma unroll 4
        for (int ks = 0; ks < 16; ++ks) {
            const f16x8 af = *(const f16x8*)(ap + ks * 16);
            const f16x8 bR = *(LAS const f16x8*)(wr_ + ks * 32), bI = *(LAS const f16x8*)(wx_ + ks * 32);
            accR = __builtin_amdgcn_mfma_f32_32x32x16_f16(af, bR, accR, 0, 0, 0);
            accI = __builtin_amdgcn_mfma_f32_32x32x16_f16(af, bI, accI, 0, 0, 0);
        }
        float a[16], bq[16];
#pragma unroll
        for (int r = 0; r < 16; ++r) { const float ucv = (float)tUC[crow(r, hi) * 32 + c]; gate_ab(accR[r], accI[r], ucv, ba, bx, cl, a[r], bq[r]); }
        float Ag[4], Bg[4], Ao[4], Bo[4];
#pragma unroll
        for (int q = 0; q < 4; ++q) { Ag[q] = a[4 * q] * a[4 * q + 1] * a[4 * q + 2] * a[4 * q + 3];
            Bg[q] = ((bq[4 * q] * a[4 * q + 1] + bq[4 * q + 1]) * a[4 * q + 2] + bq[4 * q + 2]) * a[4 * q + 3] + bq[4 * q + 3];
            Ao[q] = swap_half(Ag[q]); Bo[q] = swap_half(Bg[q]); }
        float cA = 1.f, cB = 0.f, pA[4], pB[4];
#pragma unroll
        for (int q = 0; q < 4; ++q) {
            const float eA0 = hi ? Ao[q] : Ag[q], eB0 = hi ? Bo[q] : Bg[q], eA1 = hi ? Ag[q] : Ao[q], eB1 = hi ? Bg[q] : Bo[q];
            const float c1A = cA * eA0, c1B = cB * eA0 + eB0;
            pA[q] = hi ? c1A : cA; pB[q] = hi ? c1B : cB;
            cA = c1A * eA1; cB = c1B * eA1 + eB1;
        }
        LAS float* cw = COMP + ((step & 1) * 8 * 32 + wid * 32 + c) * 2;
        if (hi == 0) { cw[0] = cA; cw[1] = cB; }
        __syncthreads();
        float h = hstep, hin = 0.f;
#pragma unroll
        for (int v = 0; v < 8; ++v) { LAS const float* cv = COMP + ((step & 1) * 8 * 32 + v * 32 + c) * 2; if (v == wid) hin = h; h = cv[0] * h + cv[1]; }
        hstep = h;
#pragma unroll
        for (int q = 0; q < 4; ++q) { float hg = pA[q] * hin + pB[q];
#pragma unroll
            for (int i = 0; i < 4; ++i) { hg = a[4 * q + i] * hg + bq[4 * q + i]; const int ti = crow(4 * q + i, hi) * 32 + c; tYH[ti] = (f16)((float)tSZ[ti] * hg); }
            if (q == 3 && step == SEQ / 256 - 1 && wid == 7 && hi == 1) F.out[O_HP + (size_t)b * D + cg] = hg; }
        { const size_t go = (rowb + tw0 + (lane >> 1)) * D + cgrp * 32 + (lane & 1) * 16;
          const u32x4 y0 = *(LAS const u32x4*)((LAS unsigned char*)tYH + lane * 32), y1 = *(LAS const u32x4*)((LAS unsigned char*)tYH + lane * 32 + 16);
          *(u32x4*)(YH + go) = y0; *(u32x4*)(YH + go + 8) = y1; }
    }
    __syncthreads();
}
__device__ __forceinline__ void scan_sample_item(Frame& F, int n) {
    const int lane = F.lane, wr = F.wave >> 2, wc = F.wave & 3, fr = lane & 15, fq = lane >> 4, t = fr & 3;
    const f16* UC = WSP(f16, WS_UC16); const f16* SZ = WSP(f16, WS_SZ16); f16* YH = WSP(f16, WS_YH); const f16* WG = WSP(f16, WS_WC_G);
    const int col0 = n * 256 + 64 * wc;
#pragma unroll 1
    for (int mh = 0; mh < 2; ++mh) {
        const int row0 = MP + 64 * wr + 32 * mh;
        f32x4 accR[2][4], accI[2][4];
#pragma unroll
        for (int m = 0; m < 2; ++m)
#pragma unroll
            for (int nn = 0; nn < 4; ++nn) { accR[m][nn] = (f32x4){0.f, 0.f, 0.f, 0.f}; accI[m][nn] = (f32x4){0.f, 0.f, 0.f, 0.f}; }
        { const f16* ap = UC + (size_t)(row0 + fr) * D + n * 256 + 8 * fq; const f16* bp = WG + (size_t)(col0 + fr) * 256 + 8 * fq;
#pragma unroll 1
          for (int k = 0; k < 256; k += 32) {
              f16x8 af[2], bR[4], bI[4];
#pragma unroll
              for (int m = 0; m < 2; ++m) af[m] = *(const f16x8*)(ap + (size_t)m * 16 * D + k);
#pragma unroll
              for (int nn = 0; nn < 4; ++nn) { bR[nn] = *(const f16x8*)(bp + (size_t)nn * 16 * 256 + k); bI[nn] = *(const f16x8*)(bp + (size_t)(1024 + nn * 16) * 256 + k); }
#pragma unroll
              for (int m = 0; m < 2; ++m)
#pragma unroll
                  for (int nn = 0; nn < 4; ++nn) { accR[m][nn] = __builtin_amdgcn_mfma_f32_16x16x32_f16(bR[nn], af[m], accR[m][nn], 0, 0, 0); accI[m][nn] = __builtin_amdgcn_mfma_f32_16x16x32_f16(bI[nn], af[m], accI[m][nn], 0, 0, 0); }
          } }
#pragma unroll
        for (int m = 0; m < 2; ++m) { const int row = row0 + 16 * m + fr, bb = (row - MP) >> 2;
#pragma unroll
            for (int nn = 0; nn < 4; ++nn) { const int cg = col0 + 16 * nn + 4 * fq; const size_t idx = (size_t)row * D + cg;
                const f16x4 uc4 = *(const f16x4*)(UC + idx), sz4 = *(const f16x4*)(SZ + idx); const f32x4 h04 = *(const f32x4*)(INF(5) + (size_t)bb * D + cg);
                const f32x4 ba4 = *(const f32x4*)(INF(20) + cg), bx4 = *(const f32x4*)(INF(22) + cg), lam4 = *(const f32x4*)(INF(23) + cg);
                f16x4 y4; f32x4 hl;
#pragma unroll
                for (int i = 0; i < 4; ++i) {
                    float a, bq; gate_ab(accR[m][nn][i], accI[m][nn][i], (float)uc4[i], ba4[i], bx4[i], -8.f * log1pf(__expf(-lam4[i])), a, bq);
                    float h = a * h04[i] + bq;
#pragma unroll
                    for (int st = 1; st < 4; ++st) { const float hp = __shfl_up(h, 1); if (t == st) h = a * hp + bq; }
                    y4[i] = (f16)((float)sz4[i] * h); hl[i] = h; }
                *(f16x4*)(YH + idx) = y4;
                if (t == 3) *(f32x4*)(F.out + O_HS + (size_t)bb * D + cg) = hl;
                __builtin_amdgcn_sched_barrier(0); } }
    }
}
__device__ __forceinline__ void phase_scan_fused(Frame& F) {
#pragma unroll 1
    for (int it = F.bid; it < BATCH * 32; it += F.nb) scan_prompt_item(F, it >> 5, it & 31);
#pragma unroll 1
    for (int it = F.bid; it < 4; it += F.nb) scan_sample_item(F, it);
}

constexpr int N_PHASES = 20;
__global__ void __launch_bounds__(NTHREADS, 2) mk_fwd(Args args) {
    extern __shared__ __attribute__((aligned(16))) unsigned char lds_raw[];
    Frame F;
    F.lds = (LAS unsigned char*)lds_raw;
    F.tid = threadIdx.x; F.lane = F.tid & 63; F.wave = __builtin_amdgcn_readfirstlane(F.tid >> 6); F.bid = blockIdx.x; F.nb = gridDim.x;
    F.ap = &args; F.out = args.out; F.ws = args.ws;
    volatile LAS unsigned* MISC = (volatile LAS unsigned*)(F.lds + LDS_BYTES - 256);
    if (F.tid < 64) MISC[F.tid] = 0u;
    __syncthreads();
    XcdBarrier bar; bar.bar = (unsigned*)(F.ws + WS_CTL) + 4096; bar.x = 0; bar.st = nullptr;
    const bool multi = (args.ph_hi - args.ph_lo) > 1;
    if (multi) bar = xcd_barrier_post((unsigned*)(F.ws + WS_CTL) + 4096, MISC + 8);
    f16* XA = WSP(f16, WS_XA);
    const int lo = args.ph_lo, hi = args.ph_hi;
#define PH(k, ...) do { if (lo <= (k) && (k) < hi) { if ((k) != lo) xcd_barrier(bar); __VA_ARGS__; } } while (0)
    PH(0, phase_prep(F));
    PH(1, { EpiStoreF16 E{WSP(f16, WS_U16), 4096, 4096}; run_gemm(F, XA, WSP(f16, WS_WA_IN0), 4096, E); });
    PH(2, phase_convgate(F, 0));
    PH(3, { EpiResid E{XA, WSP(float, WS_V32)}; run_gemm(F, WSP(f16, WS_A2), WSP(f16, WS_WA_OUT0), D, E); });
    PH(4, phase_ln(F, 0, false));
    PH(5, { EpiNsaProj E{WSP(f16, WS_Q16), WSP(float, WS_KV32), WSP(float, WS_GATES), WSP(f16, WS_SZ16), F.out, WSP(f16, WS_KV16)}; run_gemm(F, XA, WSP(f16, WS_WB_IN), NBIN_PAD, E); });
    PH(6, phase_compress_prompt(F));
    PH(7, { phase_attn_prompt(F); __syncthreads(); phase_attn_sample_mfma(F); });
    PH(8, { EpiResid E{XA, WSP(float, WS_V32)}; run_gemm(F, WSP(f16, WS_OG), WSP(f16, WS_WB_OUT), D, E); });
    PH(9, phase_ln(F, 1, false));
    PH(10, { EpiLruIn E{WSP(f16, WS_U16C), WSP(f16, WS_SZ16), F.out}; run_gemm(F, XA, WSP(f16, WS_WC_IN), 2048, E); });
    PH(11, phase_conv4(F));
    PH(13, phase_scan_fused(F));
    PH(14, { EpiResid E{XA, WSP(float, WS_V32)}; run_gemm(F, WSP(f16, WS_YH), WSP(f16, WS_WC_OUT), D, E); });
    PH(15, phase_ln(F, 2, false));
    PH(16, { EpiStoreF16 E{WSP(f16, WS_U16), 4096, 4096}; run_gemm(F, XA, WSP(f16, WS_WA_IN1), 4096, E); });
    PH(17, phase_convgate(F, 1));
    PH(18, { EpiResid E{XA, WSP(float, WS_V32)}; run_gemm(F, WSP(f16, WS_A2), WSP(f16, WS_WA_OUT1), D, E); });
    PH(19, phase_ln(F, 3, true));
#undef PH
}

extern "C" void kernel_launch(void* const* d_in, const int* in_sizes, int n_in, void* d_out, int out_size, void* d_ws, size_t ws_size, hipStream_t stream) {
    static int grid = 0;
    if (grid == 0) {
        if (n_in != 25 || out_size != (int)O_END || ws_size < WS_END) { fprintf(stderr, "kernel_launch: unexpected shapes n_in %d out %d ws %zu\n", n_in, out_size, ws_size); grid = -1; return; }
        int dev = 0, cus = 0;
        if (hipGetDevice(&dev) != hipSuccess || hipDeviceGetAttribute(&cus, hipDeviceAttributeMultiprocessorCount, dev) != hipSuccess) { grid = -1; return; }
        if (hipFuncSetAttribute((const void*)mk_fwd, hipFuncAttributeMaxDynamicSharedMemorySize, LDS_BYTES) != hipSuccess) { fprintf(stderr, "kernel_launch: hipFuncSetAttribute failed\n"); grid = -1; return; }
        int per_cu = 0;
        (void)hipOccupancyMaxActiveBlocksPerMultiprocessor(&per_cu, (const void*)mk_fwd, NTHREADS, LDS_BYTES);
        (void)hipGetLastError();
        grid = cus;
    }
    if (grid < 0) return;
    (void)hipMemsetAsync((char*)d_ws + WS_CTL, 0, CTL_BYTES, stream);
    Args a{};
    for (int i = 0; i < 25; ++i) a.in[i] = d_in[i];
    a.out = (float*)d_out; a.ws = (unsigned char*)d_ws;
#if MK_ONE_LAUNCH
    a.ph_lo = 0; a.ph_hi = N_PHASES;
    void* kargs[] = {&a};
    hipError_t e = hipLaunchCooperativeKernel((const void*)mk_fwd, dim3(grid), dim3(NTHREADS), kargs, LDS_BYTES, stream);
    if (e != hipSuccess) fprintf(stderr, "cooperative launch failed: %s\n", hipGetErrorString(e));
#else
    for (int ph = 0; ph < N_PHASES; ++ph) { a.ph_lo = ph; a.ph_hi = ph + 1; hipLaunchKernelGGL(mk_fwd, dim3(grid), dim3(NTHREADS), LDS_BYTES, stream, a); }
#endif
}
```
